# Optimizing an MI355X kernel written in HIP

```python
import jax, jax.numpy as jnp
from jax import lax
import numpy as np

D_MODEL = 1024
BATCH = 4
SEQ = 4096
DEPTH = 2

GRID_W = 64
Q_BLOCK = 128
HEAD_DIM = 64
EPS = 1e-6
ROPE_THETA = 10000.0

A_HEADS = 8
A_KV_HEADS = 2
A_GROUPS = A_HEADS // A_KV_HEADS
A_Q = A_HEADS * HEAD_DIM
A_KV = A_KV_HEADS * HEAD_DIM
A_OUT = A_Q

B_HEADS = 8
B_NOPE = 64
B_ROPE = 32
B_V = 64
B_Q_LORA = 256
B_KV_LORA = 128
B_OUT = B_HEADS * B_V

C_HEADS = 16
C_KV_HEADS = 4
C_GROUPS = C_HEADS // C_KV_HEADS
C_Q = C_HEADS * HEAD_DIM
C_KV = C_KV_HEADS * HEAD_DIM
WINDOW = 128

EVEN_IN = A_Q + 2 * A_KV + A_OUT + B_Q_LORA + B_KV_LORA + B_ROPE + B_OUT
EVEN_MIX = A_OUT + B_OUT
ODD_IN = C_Q + 2 * C_KV + C_Q
ODD_MIX = C_Q
N_EVEN = (DEPTH + 1) // 2
N_ODD = DEPTH // 2

kernel_name = "hybrid_gqa_mla_swa_adaln_encoder"


def rms_norm(x, g):
    xf = x.astype(jnp.float32)
    y = xf * lax.rsqrt(jnp.mean(xf * xf, axis=-1, keepdims=True) + EPS)
    return (y * g.astype(jnp.float32)).astype(x.dtype)


def rope_cos_sin(pos, dim):
    inv = ROPE_THETA ** (-jnp.arange(0, dim, 2, dtype=jnp.float32) / dim)
    ang = pos.astype(jnp.float32)[:, None] * inv[None, :]
    return jnp.cos(ang), jnp.sin(ang)


def apply_rope(x, cos, sin):
    half = x.shape[-1] // 2
    x1, x2 = x[..., :half], x[..., half:]
    cos = cos.astype(x.dtype)
    sin = sin.astype(x.dtype)
    return jnp.concatenate([x1 * cos - x2 * sin, x1 * sin + x2 * cos], axis=-1)


def axial_rope(x, cos_r, sin_r, cos_c, sin_c):
    half = HEAD_DIM // 2
    xr = apply_rope(x[..., :half], cos_r[:, None, :], sin_r[:, None, :])
    xc = apply_rope(x[..., half:], cos_c[:, None, :], sin_c[:, None, :])
    return jnp.concatenate([xr, xc], axis=-1)


def to_blocks(t):
    b, s = t.shape[:2]
    return jnp.moveaxis(t.reshape((b, s // Q_BLOCK, Q_BLOCK) + t.shape[2:]), 1, 0)


def from_blocks(t):
    nb, b = t.shape[:2]
    return jnp.moveaxis(t, 0, 1).reshape((b, nb * Q_BLOCK) + t.shape[3:])


def dense_gqa_attention(q, k, v):
    b, s = q.shape[:2]
    scale = HEAD_DIM ** -0.5

    def block(qi):
        sc = jnp.einsum('bqkgd,bskd->bkgqs', qi, k).astype(jnp.float32) * scale
        p = jax.nn.softmax(sc, axis=-1).astype(v.dtype)
        return jnp.einsum('bkgqs,bskd->bqkgd', p, v)

    o = from_blocks(lax.map(block, to_blocks(q)))
    return o.reshape(b, s, A_HEADS * HEAD_DIM)


def mla_attention(q_lat, q_rope, c_kv, k_rope, w_uv):
    b, s = q_lat.shape[:2]
    scale = (B_NOPE + B_ROPE) ** -0.5

    def block(args):
        ql, qr = args
        sc = (jnp.einsum('bqhc,bsc->bhqs', ql, c_kv)
              + jnp.einsum('bqhr,bsr->bhqs', qr, k_rope)).astype(jnp.float32) * scale
        p = jax.nn.softmax(sc, axis=-1).astype(c_kv.dtype)
        return jnp.einsum('bhqs,bsc->bqhc', p, c_kv)

    o_lat = from_blocks(lax.map(block, (to_blocks(q_lat), to_blocks(q_rope))))
    o = jnp.einsum('bshc,chd->bshd', o_lat, w_uv)
    return o.reshape(b, s, B_HEADS * B_V)


def windowed_sink_attention(q, k, v, sink, slopes):
    b, s = q.shape[:2]
    nb = s // Q_BLOCK
    scale = HEAD_DIM ** -0.5
    qb = q.reshape(b, nb, Q_BLOCK, C_KV_HEADS, C_GROUPS, HEAD_DIM)

    def neighbours(t):
        tb = t.reshape(b, nb, Q_BLOCK, C_KV_HEADS, HEAD_DIM)
        tp = jnp.pad(tb, ((0, 0), (1, 1), (0, 0), (0, 0), (0, 0)))
        return jnp.concatenate([tp[:, :-2], tp[:, 1:-1], tp[:, 2:]], axis=2)

    kb, vb = neighbours(k), neighbours(v)
    rel = jnp.arange(3 * Q_BLOCK)[None, :] - Q_BLOCK - jnp.arange(Q_BLOCK)[:, None]
    key_pos = (jnp.arange(nb)[:, None] - 1) * Q_BLOCK + jnp.arange(3 * Q_BLOCK)[None, :]
    valid = (jnp.abs(rel) <= WINDOW)[None] & ((key_pos >= 0) & (key_pos < s))[:, None, :]
    bias = -slopes.reshape(C_KV_HEADS, C_GROUPS)[:, :, None, None] * jnp.abs(rel).astype(jnp.float32)
    sc = jnp.einsum('bnqkgd,bnskd->bnkgqs', qb, kb).astype(jnp.float32) * scale + bias
    sc = jnp.where(valid[None, :, None, None], sc, -jnp.inf)
    sink_l = sink.astype(jnp.float32).reshape(C_KV_HEADS, C_GROUPS)[None, None, :, :, None, None]
    m = jnp.maximum(jnp.max(sc, axis=-1, keepdims=True), sink_l)
    p = jnp.exp(sc - m)
    denom = jnp.sum(p, axis=-1, keepdims=True) + jnp.exp(sink_l - m)
    o = jnp.einsum('bnkgqs,bnskd->bnqkgd', (p / denom).astype(v.dtype), vb)
    return o.reshape(b, s, C_HEADS * HEAD_DIM)


def even_mixer(h, w_in, q_norm_a, k_norm_a, q_lora_norm, kv_lora_norm, w_uq, w_uk, w_uv, w_out,
               cos_r, sin_r, cos_c, sin_c, cos_t, sin_t):
    b, s, _ = h.shape
    proj = h @ w_in
    splits = list(np.cumsum([A_Q, A_KV, A_KV, A_OUT, B_Q_LORA, B_KV_LORA, B_ROPE]))
    qa, ka, va, ga, cq, ckv, kr, gb = jnp.split(proj, splits, axis=-1)
    qa = axial_rope(rms_norm(qa.reshape(b, s, A_HEADS, HEAD_DIM), q_norm_a), cos_r, sin_r, cos_c, sin_c)
    ka = axial_rope(rms_norm(ka.reshape(b, s, A_KV_HEADS, HEAD_DIM), k_norm_a), cos_r, sin_r, cos_c, sin_c)
    oa = dense_gqa_attention(qa.reshape(b, s, A_KV_HEADS, A_GROUPS, HEAD_DIM), ka,
                             va.reshape(b, s, A_KV_HEADS, HEAD_DIM))
    oa = oa * jax.nn.silu(ga)
    cq = rms_norm(cq, q_lora_norm)
    ckv = rms_norm(ckv, kv_lora_norm)
    qb = (cq @ w_uq).reshape(b, s, B_HEADS, B_NOPE + B_ROPE)
    q_nope, q_rope = qb[..., :B_NOPE], qb[..., B_NOPE:]
    q_rope = apply_rope(q_rope, cos_t[:, None, :], sin_t[:, None, :])
    k_rope = apply_rope(kr, cos_t, sin_t)
    q_lat = jnp.einsum('bshd,chd->bshc', q_nope, w_uk)
    ob = mla_attention(q_lat, q_rope, ckv, k_rope, w_uv) * jax.nn.silu(gb)
    return jnp.concatenate([oa, ob], axis=-1) @ w_out


def odd_mixer(h, w_in, sink, w_out, slopes):
    b, s, _ = h.shape
    proj = h @ w_in
    qc, kc, vc, gc = jnp.split(proj, [C_Q, C_Q + C_KV, C_Q + 2 * C_KV], axis=-1)
    oc = windowed_sink_attention(qc.reshape(b, s, C_KV_HEADS, C_GROUPS, HEAD_DIM),
                                 kc.reshape(b, s, C_KV_HEADS, HEAD_DIM),
                                 vc.reshape(b, s, C_KV_HEADS, HEAD_DIM), sink, slopes)
    return (oc * jax.nn.silu(gc)) @ w_out


def setup_inputs(seed: int = 0) -> dict:
    key = jax.random.key(seed)
    ks = jax.random.split(key, 20)
    f32 = jnp.float32
    nrm = lambda k, shape, s: jax.random.normal(k, shape, f32) * s
    gain = lambda k, shape: 1.0 + 0.02 * jax.random.normal(k, shape, f32)
    return {
        "x": nrm(ks[0], (BATCH, SEQ, D_MODEL), 1.0),
        "c": nrm(ks[1], (BATCH, D_MODEL), 1.0),
        "norm_w": gain(ks[2], (DEPTH, D_MODEL)),
        "ada_w": nrm(ks[3], (DEPTH, D_MODEL, 3 * D_MODEL), 0.02),
        "ada_b": nrm(ks[4], (DEPTH, 3 * D_MODEL), 0.02),
        "even_w_in": nrm(ks[5], (N_EVEN, D_MODEL, EVEN_IN), D_MODEL ** -0.5),
        "a_q_norm": gain(ks[6], (N_EVEN, HEAD_DIM)),
        "a_k_norm": gain(ks[7], (N_EVEN, HEAD_DIM)),
        "b_q_lora_norm": gain(ks[8], (N_EVEN, B_Q_LORA)),
        "b_kv_lora_norm": gain(ks[9], (N_EVEN, B_KV_LORA)),
        "b_w_uq": nrm(ks[10], (N_EVEN, B_Q_LORA, B_HEADS * (B_NOPE + B_ROPE)), B_Q_LORA ** -0.5),
        "b_w_uk": nrm(ks[11], (N_EVEN, B_KV_LORA, B_HEADS, B_NOPE), B_KV_LORA ** -0.5),
        "b_w_uv": nrm(ks[12], (N_EVEN, B_KV_LORA, B_HEADS, B_V), B_KV_LORA ** -0.5),
        "even_w_out": nrm(ks[13], (N_EVEN, EVEN_MIX, D_MODEL), EVEN_MIX ** -0.5),
        "odd_w_in": nrm(ks[14], (N_ODD, D_MODEL, ODD_IN), D_MODEL ** -0.5),
        "c_sink": nrm(ks[15], (N_ODD, C_HEADS), 0.5),
        "odd_w_out": nrm(ks[16], (N_ODD, ODD_MIX, D_MODEL), ODD_MIX ** -0.5),
        "final_norm": gain(ks[17], (D_MODEL,)),
    }


def reference(x, c, norm_w, ada_w, ada_b, even_w_in, a_q_norm, a_k_norm, b_q_lora_norm,
              b_kv_lora_norm, b_w_uq, b_w_uk, b_w_uv, even_w_out, odd_w_in, c_sink, odd_w_out,
              final_norm):
    s = x.shape[1]
    rows = s // GRID_W
    row = jnp.repeat(jnp.arange(rows), GRID_W)
    col = jnp.tile(jnp.arange(GRID_W), rows)
    tok = jnp.arange(s)
    cos_r, sin_r = rope_cos_sin(row, HEAD_DIM // 2)
    cos_c, sin_c = rope_cos_sin(col, HEAD_DIM // 2)
    cos_t, sin_t = rope_cos_sin(tok, B_ROPE)
    slopes = 2.0 ** (-8.0 * jnp.arange(1, C_HEADS + 1, dtype=jnp.float32) / C_HEADS)
    c_act = jax.nn.silu(c)
    for layer in range(DEPTH):
        mod = c_act @ ada_w[layer] + ada_b[layer]
        shift, scale, gate = jnp.split(mod, 3, axis=-1)
        h = rms_norm(x, norm_w[layer]) * (1.0 + scale[:, None, :]) + shift[:, None, :]
        if layer % 2 == 0:
            i = layer // 2
            y = even_mixer(h, even_w_in[i], a_q_norm[i], a_k_norm[i], b_q_lora_norm[i],
                           b_kv_lora_norm[i], b_w_uq[i], b_w_uk[i], b_w_uv[i], even_w_out[i],
                           cos_r, sin_r, cos_c, sin_c, cos_t, sin_t)
        else:
            i = layer // 2
            y = odd_mixer(h, odd_w_in[i], c_sink[i], odd_w_out[i], slopes)
        x = x + gate[:, None, :] * y
    return rms_norm(x, final_norm)
```

```cpp
#include <hip/hip_runtime.h>
#include <hip/hip_cooperative_groups.h>
#include <cstdio>
#include <cstdint>
#include <cmath>
namespace cg = cooperative_groups;
namespace pg8 {
#define PG8_LAS __attribute__((address_space(3)))
typedef unsigned short bf16_t;
typedef short bf16x8 __attribute__((ext_vector_type(8)));
typedef float f32x4 __attribute__((ext_vector_type(4)));
typedef unsigned u32x4 __attribute__((ext_vector_type(4)));
constexpr int BM = 256, BK = 64, HALF = 128, HTB = HALF * BK * 2  , STAGE_BYTES = 8 * HTB, NXCD = 8, WGM = 8;

__host__ __device__ __forceinline__ int lds_byte(int r, int c) { const int st = (r >> 4) * 2 + (c >> 5), rr = r & 15, cc = c & 31, ob = rr * 64 + cc * 2; return st * 1024 + (ob ^ (((ob >> 9) & 1) << 5)); }
__host__ __device__ __forceinline__ void stage_rc(int b, int& R, int& C) { const int st = b / 1024, sb = b % 1024, swz = sb ^ (((sb >> 9) & 1) << 5); R = (st >> 1) * 16 + swz / 64; C = (st & 1) * 32 + (swz % 64) / 2; }
__host__ __device__ __forceinline__ int perm32(int rho) { const int n = rho >> 4, i = rho & 15; return 8 * (i >> 2) + 4 * n + (i & 3); }

struct Unit { int pm, pn; };
struct Gemm { const bf16_t* A; const bf16_t* Bt; int M, N, K, lda; };

struct StaticOrder {
    int nM, nN, nwg, G, c;
    __host__ __device__ void init(int M, int N, int G_, int c_) { nM = M / BM; nN = N / BM; nwg = nM * nN; G = G_; c = c_; }
    __host__ __device__ bool next(int i, Unit& u) const {
        const long L = (long)i * G + c; if (L >= nwg) return false;
        int wgid = (int)L; { const int q = nwg / NXCD, r = nwg % NXCD, xcd = wgid % NXCD, off = wgid / NXCD; wgid = (xcd < r ? xcd * (q + 1) : r * (q + 1) + (xcd - r) * q) + off; }
        const int nig = WGM * nN, gid = wgid / nig, fm = gid * WGM, gsz = (nM - fm) < WGM ? (nM - fm) : WGM;
        u.pm = fm + ((wgid % nig) % gsz); u.pn = (wgid % nig) / gsz; return true;
    }
    __device__ __forceinline__ void a_ready(const Unit&) const {}
    __device__ __forceinline__ void done(const Unit&) const {}
};

__device__ __forceinline__ unsigned cvt_pk_bf16(float lo, float hi) { unsigned r; asm volatile("v_cvt_pk_bf16_f32 %0, %1, %2" : "=v"(r) : "v"(lo), "v"(hi)); return r; }
typedef float f32x2 __attribute__((ext_vector_type(2)));
template <class Epi, class Sched, bool ALIGN_EPI = false, bool SP2 = false>
__device__ __forceinline__ void gemm_phase(PG8_LAS unsigned char* lds, const Gemm g, const Sched& S, const Epi& E) {
    const int tid = threadIdx.x, wid = __builtin_amdgcn_readfirstlane(tid >> 6), lane = tid & 63, wr = wid >> 2, wc = wid & 3, fr = lane & 15, fq = lane >> 4;
    const int K = g.K, nt = K / BK;
    unsigned voffA[2], voffB[2];
#pragma unroll
    for (int i = 0; i < 2; ++i) { int R, C; stage_rc(tid * 16 + i * 8192, R, C); const int Rb = Epi::PERM ? ((R & ~31) + perm32(R & 31)) : R;
        voffA[i] = (unsigned)(R * g.lda + C) * 2u; voffB[i] = (unsigned)(Rb * K + C) * 2u; }
    const size_t kstep = (size_t)(BK * 2);
    const size_t hstepA = (size_t)HALF * g.lda * 2, hstepB = (size_t)HALF * K * 2;
    const size_t tstepA = 2 * hstepA, tstepB = 2 * hstepB;
    const unsigned ldsw = (unsigned)wid * 1024u;
    const int aoff = lds_byte(wr * 64 + fr, fq * 8), boff = lds_byte(wc * 32 + fr, fq * 8);
#define PG8_SA(b, h) (((b) * 2 + (h)) * HTB)
#define PG8_SB(b, h) ((4 + (b) * 2 + (h)) * HTB)
#define PG8_STAGE(bufoff, gbase, voff) do { _Pragma("unroll") for (int _i = 0; _i < 2; ++_i) \
        __builtin_amdgcn_global_load_lds((const unsigned*)((const char*)(gbase) + (voff)[_i]), (PG8_LAS unsigned*)(lds + (bufoff) + ldsw + _i * 8192), 16, 0, 0); } while (0)
#define PG8_LDA(dst, b, h) do { _Pragma("unroll") for (int m = 0; m < 4; ++m) _Pragma("unroll") for (int k = 0; k < 2; ++k) dst[m][k] = *(const PG8_LAS bf16x8*)(lds + PG8_SA(b, h) + aoff + m * 2048 + k * 1024); } while (0)
#define PG8_LDB(dst, b, h) do { _Pragma("unroll") for (int n = 0; n < 2; ++n) _Pragma("unroll") for (int k = 0; k < 2; ++k) dst[n][k] = *(const PG8_LAS bf16x8*)(lds + PG8_SB(b, h) + boff + n * 2048 + k * 1024); } while (0)
#define PG8_MMA(ai, bj, At, Bt) do { __builtin_amdgcn_s_setprio(1); _Pragma("unroll") for (int m = 0; m < 4; ++m) _Pragma("unroll") for (int n = 0; n < 2; ++n) _Pragma("unroll") for (int k = 0; k < 2; ++k) \
        acc[ai][bj][m][n] = __builtin_amdgcn_mfma_f32_16x16x32_bf16(Bt[n][k], At[m][k], acc[ai][bj][m][n], 0, 0, 0); __builtin_amdgcn_s_setprio(0); } while (0)
#define PG8_WAIT_V(n) asm volatile("s_waitcnt vmcnt(" #n ")" ::: "memory")
#define PG8_WAIT_L(n) asm volatile("s_waitcnt lgkmcnt(" #n ")" ::: "memory")
#define PG8_BAR __builtin_amdgcn_s_barrier()
#define PG8_SCHED __builtin_amdgcn_sched_barrier(0)
    Unit cur, nxt; int ui = 0;
    if (!S.next(0, cur)) return;
    f32x4 acc[2][2][4][2];
#pragma unroll
    for (int a = 0; a < 2; ++a)
#pragma unroll
        for (int b = 0; b < 2; ++b)
#pragma unroll
            for (int m = 0; m < 4; ++m)
#pragma unroll
                for (int n = 0; n < 2; ++n) acc[a][b][m][n] = (f32x4){0.f, 0.f, 0.f, 0.f};
    bf16x8 At[4][2], B0[2][2], B1[2][2];
    const char* cA = (const char*)g.A + (size_t)cur.pm * tstepA; const char* cB = (const char*)g.Bt + (size_t)cur.pn * tstepB;
    S.a_ready(cur);
    if constexpr (SP2) {
        PG8_STAGE(PG8_SB(0, 0), cB, voffB); PG8_STAGE(PG8_SB(0, 1), cB + hstepB, voffB); PG8_STAGE(PG8_SA(0, 0), cA, voffA); PG8_STAGE(PG8_SA(0, 1), cA + hstepA, voffA);
        if (wr == 1) PG8_BAR;
        PG8_WAIT_V(2); PG8_BAR;
        PG8_STAGE(PG8_SB(1, 0), cB + kstep, voffB); PG8_STAGE(PG8_SA(1, 0), cA + kstep, voffA); PG8_STAGE(PG8_SB(1, 1), cB + hstepB + kstep, voffB);
        PG8_WAIT_V(6); PG8_BAR;
    } else {
        PG8_STAGE(PG8_SB(0, 0), cB, voffB); PG8_STAGE(PG8_SA(0, 0), cA, voffA); PG8_STAGE(PG8_SB(0, 1), cB + hstepB, voffB); PG8_STAGE(PG8_SA(0, 1), cA + hstepA, voffA);
        if (wr == 1) PG8_BAR;
        PG8_WAIT_V(4); PG8_BAR;
        PG8_STAGE(PG8_SB(1, 0), cB + kstep, voffB); PG8_STAGE(PG8_SA(1, 0), cA + kstep, voffA); PG8_STAGE(PG8_SB(1, 1), cB + hstepB + kstep, voffB);
        PG8_WAIT_V(6); PG8_BAR;
    }
    for (;;) {
        const bool has_next = S.next(ui + 1, nxt);
        const char* nA = has_next ? (const char*)g.A + (size_t)nxt.pm * tstepA : cA; const char* nB = has_next ? (const char*)g.Bt + (size_t)nxt.pn * tstepB : cB;
        for (int t = 0; t < nt; t += 2) {
            const bool last = (t == nt - 2);
            const char* a1 = cA + (size_t)(t + 1) * kstep;
            const char* a2 = last ? nA : cA + (size_t)(t + 2) * kstep; const char* b2 = last ? nB : cB + (size_t)(t + 2) * kstep;
            const char* a3 = a2 + kstep; const char* b3 = b2 + kstep;
            if (last && has_next) S.a_ready(nxt);
            if constexpr (SP2) {
            PG8_LDB(B0, 0, 0); PG8_LDB(B1, 0, 1); PG8_SCHED; PG8_LDA(At, 0, 0); PG8_STAGE(PG8_SA(1, 1), a1 + hstepA, voffA);
            PG8_WAIT_V(8); PG8_WAIT_L(0); PG8_BAR; PG8_MMA(0, 0, At, B0); PG8_MMA(0, 1, At, B1); PG8_BAR; PG8_SCHED;
            PG8_LDA(At, 0, 1); PG8_STAGE(PG8_SB(0, 0), b2, voffB); PG8_STAGE(PG8_SB(0, 1), b2 + hstepB, voffB); PG8_STAGE(PG8_SA(0, 0), a2, voffA);
            PG8_WAIT_V(8); PG8_WAIT_L(0); PG8_BAR; PG8_MMA(1, 0, At, B0); PG8_MMA(1, 1, At, B1); PG8_BAR; PG8_SCHED;
            PG8_LDB(B0, 1, 0); PG8_LDB(B1, 1, 1); PG8_SCHED; PG8_LDA(At, 1, 0); PG8_STAGE(PG8_SA(0, 1), a2 + hstepA, voffA);
            PG8_WAIT_V(8); PG8_WAIT_L(0); PG8_BAR; PG8_MMA(0, 0, At, B0); PG8_MMA(0, 1, At, B1); PG8_BAR; PG8_SCHED;
            PG8_LDA(At, 1, 1); PG8_STAGE(PG8_SB(1, 0), b3, voffB); PG8_STAGE(PG8_SB(1, 1), b3 + hstepB, voffB); PG8_STAGE(PG8_SA(1, 0), a3, voffA);
            PG8_WAIT_V(8); PG8_WAIT_L(0); PG8_BAR; PG8_MMA(1, 0, At, B0); PG8_MMA(1, 1, At, B1); PG8_BAR; PG8_SCHED;
            } else {
            PG8_LDB(B0, 0, 0); PG8_SCHED; PG8_LDA(At, 0, 0); PG8_STAGE(PG8_SA(1, 1), a1 + hstepA, voffA);
            PG8_WAIT_L(8); PG8_BAR; PG8_WAIT_L(0); PG8_MMA(0, 0, At, B0); PG8_BAR; PG8_SCHED;
            PG8_LDB(B1, 0, 1); PG8_STAGE(PG8_SB(0, 0), b2, voffB);
            PG8_BAR; PG8_WAIT_L(0); PG8_MMA(0, 1, At, B1); PG8_BAR;
            PG8_LDA(At, 0, 1); PG8_STAGE(PG8_SA(0, 0), a2, voffA);
            PG8_BAR; PG8_WAIT_L(0); PG8_MMA(1, 0, At, B0); PG8_BAR; PG8_SCHED;
            PG8_STAGE(PG8_SB(0, 1), b2 + hstepB, voffB);
            PG8_WAIT_V(6); PG8_BAR; PG8_MMA(1, 1, At, B1); PG8_BAR;
            PG8_LDB(B0, 1, 0); PG8_SCHED; PG8_LDA(At, 1, 0); PG8_STAGE(PG8_SA(0, 1), a2 + hstepA, voffA);
            PG8_WAIT_L(8); PG8_BAR; PG8_WAIT_L(0); PG8_MMA(0, 0, At, B0); PG8_BAR; PG8_SCHED;
            PG8_LDB(B1, 1, 1); PG8_STAGE(PG8_SB(1, 0), b3, voffB);
            PG8_BAR; PG8_WAIT_L(0); PG8_MMA(0, 1, At, B1); PG8_BAR;
            PG8_LDA(At, 1, 1); PG8_STAGE(PG8_SA(1, 0), a3, voffA);
            PG8_BAR; PG8_WAIT_L(0); PG8_MMA(1, 0, At, B0); PG8_BAR; PG8_SCHED;
            PG8_STAGE(PG8_SB(1, 1), b3 + hstepB, voffB);
            PG8_WAIT_V(6); PG8_BAR; PG8_MMA(1, 1, At, B1); PG8_BAR;
            }
        }
        if constexpr (ALIGN_EPI) { if (wr == 0) PG8_BAR; }
        if constexpr (!Epi::AFTER_DRAIN) { E(acc, cur, wr, wc, fr, fq); S.done(cur); }
        if (!has_next) break;
#pragma unroll
        for (int a = 0; a < 2; ++a)
#pragma unroll
            for (int b = 0; b < 2; ++b)
#pragma unroll
                for (int m = 0; m < 4; ++m)
#pragma unroll
                    for (int n = 0; n < 2; ++n) acc[a][b][m][n] = (f32x4){0.f, 0.f, 0.f, 0.f};
        cur = nxt; cA = nA; cB = nB; ++ui;
        if constexpr (ALIGN_EPI) { if (wr == 1) PG8_BAR; }
    }
    PG8_WAIT_V(0);
    if constexpr (!ALIGN_EPI) { if (wr == 0) PG8_BAR; }
    PG8_BAR;
    if constexpr (Epi::AFTER_DRAIN) { E.fused(acc, cur, wr, wc, fr, fq, lds, wid, lane); S.done(cur); }
#undef PG8_SA
#undef PG8_SB
#undef PG8_STAGE
#undef PG8_LDA
#undef PG8_LDB
#undef PG8_MMA
#undef PG8_WAIT_V
#undef PG8_WAIT_L
#undef PG8_BAR
#undef PG8_SCHED
}
}
#define PG8_SP2 true
#define PG8_ALIGN true
namespace pg8 {
typedef unsigned u32x2 __attribute__((ext_vector_type(2)));
struct EpiStore {
    static constexpr bool PERM = true, AFTER_DRAIN = false;
    bf16_t* O; int ldc; int scale_cols; float scale0;
    __device__ __forceinline__ void operator()(const f32x4 (&acc)[2][2][4][2], const Unit& u, int wr, int wc, int fr, int fq) const {
        const int row0 = u.pm * BM + wr * 64 + fr; const int col0 = u.pn * BM + wc * 32 + 8 * fq;
        const float sc = (u.pn * BM < scale_cols) ? scale0 : 1.f;
#pragma unroll
        for (int ai = 0; ai < 2; ++ai)
#pragma unroll
            for (int m = 0; m < 4; ++m) { bf16_t* rowp = O + (size_t)(row0 + ai * HALF + m * 16) * ldc + col0;
#pragma unroll
                for (int bj = 0; bj < 2; ++bj) { f32x4 v0 = acc[ai][bj][m][0] * sc, v1 = acc[ai][bj][m][1] * sc;
                    u32x4 w; w.x = cvt_pk_bf16(v0[0], v0[1]); w.y = cvt_pk_bf16(v0[2], v0[3]); w.z = cvt_pk_bf16(v1[0], v1[1]); w.w = cvt_pk_bf16(v1[2], v1[3]);
                    *(u32x4*)(rowp + bj * HALF) = w; } }
    }
};
struct EpiQb {
    static constexpr bool PERM = false, AFTER_DRAIN = false;
    bf16_t* O; int ldc; const float2* rope; float sc;
    __device__ __forceinline__ void operator()(const f32x4 (&acc)[2][2][4][2], const Unit& u, int wr, int wc, int fr, int fq) const {
        const int row0 = u.pm * BM + wr * 64 + fr;
#pragma unroll
        for (int bj = 0; bj < 2; ++bj) { const int colg = u.pn * BM + bj * HALF + wc * 32; const bool is_rope = ((colg >> 5) % 3) == 2;
#pragma unroll
            for (int ai = 0; ai < 2; ++ai)
#pragma unroll
                for (int m = 0; m < 4; ++m) { const int row = row0 + ai * HALF + m * 16; f32x4 v0 = acc[ai][bj][m][0], v1 = acc[ai][bj][m][1];
                    if (is_rope) { const float2* rp = rope + (size_t)(row & 4095) * 16 + 4 * fq;
#pragma unroll
                        for (int e = 0; e < 4; ++e) { const float2 cs = rp[e]; const float x1 = v0[e], x2 = v1[e]; v0[e] = x1 * cs.x - x2 * cs.y; v1[e] = x1 * cs.y + x2 * cs.x; } }
                    v0 = v0 * sc; v1 = v1 * sc; bf16_t* rowp = O + (size_t)row * ldc + colg + 4 * fq;
                    u32x2 a, b; a.x = cvt_pk_bf16(v0[0], v0[1]); a.y = cvt_pk_bf16(v0[2], v0[3]); b.x = cvt_pk_bf16(v1[0], v1[1]); b.y = cvt_pk_bf16(v1[2], v1[3]);
                    *(u32x2*)rowp = a; *(u32x2*)(rowp + 16) = b; asm volatile("" ::: "memory"); } }
    }
};
struct EpiRes {
    static constexpr bool PERM = true, AFTER_DRAIN = false;
    const float* base; float* out; const float* gate; int ldc;
    __device__ __forceinline__ void operator()(const f32x4 (&acc)[2][2][4][2], const Unit& u, int wr, int wc, int fr, int fq) const {
        const int row0 = u.pm * BM + wr * 64 + fr; const int b = (u.pm * BM) >> 12; const int col0 = u.pn * BM + wc * 32 + 8 * fq;
#pragma unroll
        for (int bj = 0; bj < 2; ++bj) { const int col = col0 + bj * HALF; const f32x4 g0 = *(const f32x4*)(gate + (size_t)b * 3072 + col), g1 = *(const f32x4*)(gate + (size_t)b * 3072 + col + 4);
#pragma unroll
            for (int ai = 0; ai < 2; ++ai)
#pragma unroll
                for (int m = 0; m < 4; ++m) { const size_t off = (size_t)(row0 + ai * HALF + m * 16) * ldc + col;
                    const f32x4 b0 = *(const f32x4*)(base + off), b1 = *(const f32x4*)(base + off + 4);
                    *(f32x4*)(out + off) = b0 + g0 * acc[ai][bj][m][0]; *(f32x4*)(out + off + 4) = b1 + g1 * acc[ai][bj][m][1]; } }
    }
};
struct PanelRms {
    float* xbuf; unsigned* cnt; float eps;
    __device__ __forceinline__ void run(const f32x4 (&v)[2][2][4][2], const Unit& u, int wr, int wc, int fr, int fq, PG8_LAS unsigned char* lds, int wid, int lane) const {
        PG8_LAS float* Pp = (PG8_LAS float*)lds;
        PG8_LAS float* S = (PG8_LAS float*)(lds + 4096);
#pragma unroll
        for (int ai = 0; ai < 2; ++ai)
#pragma unroll
            for (int m = 0; m < 4; ++m) { float q = 0.f;
#pragma unroll
                for (int bj = 0; bj < 2; ++bj)
#pragma unroll
                    for (int n = 0; n < 2; ++n) { const f32x4 x = v[ai][bj][m][n]; q += (x[0] * x[0] + x[1] * x[1]) + (x[2] * x[2] + x[3] * x[3]); }
                q += __shfl_xor(q, 16); q += __shfl_xor(q, 32);
                if (fq == 0) Pp[(ai * HALF + wr * 64 + m * 16 + fr) * 4 + wc] = q; }
        asm volatile("s_waitcnt lgkmcnt(0)" ::: "memory"); __builtin_amdgcn_s_barrier(); asm volatile("" ::: "memory");
        const int row = wid * 32 + (lane & 31);
        if (lane < 32) { const f32x4 a = *(const PG8_LAS f32x4*)(Pp + row * 4);
            __hip_atomic_store(xbuf + ((size_t)(u.pm * BM + row) * 4 + u.pn), (a[0] + a[1]) + (a[2] + a[3]), __ATOMIC_RELAXED, __HIP_MEMORY_SCOPE_AGENT); }
        asm volatile("s_waitcnt vmcnt(0)" ::: "memory");
        if (lane == 0) __hip_atomic_fetch_add(cnt + 64 * u.pm, 1u, __ATOMIC_RELAXED, __HIP_MEMORY_SCOPE_AGENT);
        if (wid == 0) {
            for (unsigned sp = 0; sp < (1u << 22); ++sp) {
                if ((unsigned)__builtin_amdgcn_readfirstlane(__hip_atomic_load(cnt + 64 * u.pm, __ATOMIC_RELAXED, __HIP_MEMORY_SCOPE_AGENT)) >= 32u) break;
                __builtin_amdgcn_s_sleep(2); }
            __builtin_amdgcn_fence(__ATOMIC_ACQUIRE, "agent");
        }
        asm volatile("s_waitcnt vmcnt(0) lgkmcnt(0)" ::: "memory"); __builtin_amdgcn_s_barrier(); asm volatile("" ::: "memory");
        if (lane < 32) { const float* slot = xbuf + (size_t)(u.pm * BM + row) * 4; float q = 0.f;
#pragma unroll
            for (int t = 0; t < 4; ++t) q += __hip_atomic_load(slot + t, __ATOMIC_RELAXED, __HIP_MEMORY_SCOPE_AGENT);
            S[row] = 1.0f / sqrtf(q * (1.0f / 1024.0f) + eps); }
        asm volatile("s_waitcnt vmcnt(0) lgkmcnt(0)" ::: "memory"); __builtin_amdgcn_s_barrier(); asm volatile("" ::: "memory");
    }
};
template <bool FINAL> struct EpiResNorm {
    static constexpr bool PERM = true, AFTER_DRAIN = true;
    const float* base; float* out; const float* gate; int ldc; PanelRms st; const float* nw; const float* modn; bf16_t* Hn; bf16_t* x1b;
    __device__ __forceinline__ void operator()(const f32x4 (&)[2][2][4][2], const Unit&, int, int, int, int) const {}
    __device__ __forceinline__ void fused(f32x4 (&acc)[2][2][4][2], const Unit& u, int wr, int wc, int fr, int fq, PG8_LAS unsigned char* lds, int wid, int lane) const {
        const int row0 = u.pm * BM + wr * 64 + fr; const int b = (u.pm * BM) >> 12; const int col0 = u.pn * BM + wc * 32 + 8 * fq;
#pragma unroll
        for (int bj = 0; bj < 2; ++bj) { const int col = col0 + bj * HALF; const f32x4 g0 = *(const f32x4*)(gate + (size_t)b * 3072 + col), g1 = *(const f32x4*)(gate + (size_t)b * 3072 + col + 4);
#pragma unroll
            for (int ai = 0; ai < 2; ++ai)
#pragma unroll
                for (int m = 0; m < 4; ++m) { const size_t off = (size_t)(row0 + ai * HALF + m * 16) * ldc + col;
                    f32x4 b0, b1;
                    if (FINAL) { const u32x4 rw = *(const u32x4*)(x1b + off);
                        b0 = (f32x4){__uint_as_float(rw.x << 16), __uint_as_float(rw.x & 0xffff0000u), __uint_as_float(rw.y << 16), __uint_as_float(rw.y & 0xffff0000u)};
                        b1 = (f32x4){__uint_as_float(rw.z << 16), __uint_as_float(rw.z & 0xffff0000u), __uint_as_float(rw.w << 16), __uint_as_float(rw.w & 0xffff0000u)}; }
                    else { b0 = *(const f32x4*)(base + off); b1 = *(const f32x4*)(base + off + 4); }
                    acc[ai][bj][m][0] = b0 + g0 * acc[ai][bj][m][0]; acc[ai][bj][m][1] = b1 + g1 * acc[ai][bj][m][1];
                    asm volatile("" : "+v"(acc[ai][bj][m][0]), "+v"(acc[ai][bj][m][1]));
                    if (m == 3) asm volatile("" ::: "memory"); } }
        f32x4 ww0[2], ww1[2], hh0[2], hh1[2];
#pragma unroll
        for (int bj = 0; bj < 2; ++bj) { const int col = col0 + bj * HALF;
            ww0[bj] = *(const f32x4*)(nw + col); ww1[bj] = *(const f32x4*)(nw + col + 4); hh0[bj] = (f32x4){0.f, 0.f, 0.f, 0.f}; hh1[bj] = hh0[bj];
            if (!FINAL) { const float* mb = modn + (size_t)b * 3072; ww0[bj] = ww0[bj] * (*(const f32x4*)(mb + 1024 + col) + 1.f); ww1[bj] = ww1[bj] * (*(const f32x4*)(mb + 1024 + col + 4) + 1.f); hh0[bj] = *(const f32x4*)(mb + col); hh1[bj] = *(const f32x4*)(mb + col + 4); } }
        st.run(acc, u, wr, wc, fr, fq, lds, wid, lane);
        const PG8_LAS float* S = (const PG8_LAS float*)(lds + 4096);
#pragma unroll
        for (int bj = 0; bj < 2; ++bj) { const int col = col0 + bj * HALF;
            const f32x4 w0 = ww0[bj], w1 = ww1[bj], h0 = hh0[bj], h1 = hh1[bj];
#pragma unroll
            for (int ai = 0; ai < 2; ++ai)
#pragma unroll
                for (int m = 0; m < 4; ++m) { const int r = ai * HALF + wr * 64 + m * 16 + fr; const float rstd = S[r]; const size_t off = (size_t)(u.pm * BM + r) * ldc + col;
                    const f32x4 x0 = acc[ai][bj][m][0], x1 = acc[ai][bj][m][1];
                    if (FINAL) { *(f32x4*)(out + off) = x0 * rstd * w0; *(f32x4*)(out + off + 4) = x1 * rstd * w1; }
                    else { { u32x4 xw; xw.x = cvt_pk_bf16(x0[0], x0[1]); xw.y = cvt_pk_bf16(x0[2], x0[3]); xw.z = cvt_pk_bf16(x1[0], x1[1]); xw.w = cvt_pk_bf16(x1[2], x1[3]); *(u32x4*)(x1b + off) = xw; }
                        const f32x4 y0 = x0 * rstd * w0 + h0, y1 = x1 * rstd * w1 + h1;
                        u32x4 w; w.x = cvt_pk_bf16(y0[0], y0[1]); w.y = cvt_pk_bf16(y0[2], y0[3]); w.z = cvt_pk_bf16(y1[0], y1[1]); w.w = cvt_pk_bf16(y1[2], y1[3]);
                        *(u32x4*)(Hn + off) = w; }
                    if (m & 1) asm volatile("" ::: "memory"); } }
    }
};
}
namespace att {
#define LAS3 __attribute__((address_space(3)))
typedef unsigned short bf16_t;
typedef short bf16x8 __attribute__((ext_vector_type(8)));
typedef short s16x4 __attribute__((ext_vector_type(4)));
typedef float f32x16 __attribute__((ext_vector_type(16)));
typedef float f32x4 __attribute__((ext_vector_type(4)));
typedef unsigned u32x4 __attribute__((ext_vector_type(4)));
typedef float f32x2_t __attribute__((ext_vector_type(2)));
typedef __bf16 bf16x2_t __attribute__((ext_vector_type(2)));
constexpr int KSLOT = 14336, VSLOT = 8192;
constexpr int L_K = 0, L_V = 2 * KSLOT, L_WS = L_V + 2 * VSLOT, L_OST = L_WS + 8 * 256, L_BYTES = L_OST + 8 * 4096;
__device__ __forceinline__ int crow(int r, int hi) { return (r & 3) + 8 * (r >> 2) + 4 * hi; }
__device__ __forceinline__ unsigned cvtpk(float lo, float hi) { f32x2_t v = {lo, hi}; bf16x2_t b = __builtin_convertvector(v, bf16x2_t); return __builtin_bit_cast(unsigned, b); }
__device__ __forceinline__ float bflo(unsigned u) { return __uint_as_float(u << 16); }
__device__ __forceinline__ float bfhi(unsigned u) { return __uint_as_float(u & 0xffff0000u); }
__device__ __forceinline__ s16x4 vtr(const LAS3 char* p) { return __builtin_bit_cast(s16x4, __builtin_amdgcn_ds_read_tr16_b64_v4i16((LAS3 s16x4*)p)); }
__device__ __forceinline__ float swapmax(float m) { auto rr = __builtin_amdgcn_permlane32_swap(__float_as_uint(m), __float_as_uint(m), false, false); return fmaxf(__uint_as_float(rr[0]), __uint_as_float(rr[1])); }
__device__ __forceinline__ float swapsum(float m) { auto rr = __builtin_amdgcn_permlane32_swap(__float_as_uint(m), __float_as_uint(m), false, false); return __uint_as_float(rr[0]) + __uint_as_float(rr[1]); }
__device__ __forceinline__ float silu_f(float g) { return g * __builtin_amdgcn_rcpf(1.f + __builtin_amdgcn_exp2f(-1.4426950408889634f * g)); }

__device__ __forceinline__ void glds16s(const void* sbase, unsigned voff, unsigned lds_dst) { unsigned keep;
    asm volatile("s_mov_b32 %0, m0\n\ts_mov_b32 m0, %3\n\ts_nop 0\n\tglobal_load_lds_dwordx4 %1, %2\n\ts_mov_b32 m0, %0" : "=&s"(keep) : "v"(voff), "s"(sbase), "s"(lds_dst) : "memory"); }
}
namespace att2 {
using namespace att;
constexpr int M_K = 0, M_V = 2 * KSLOT, M_WS = M_V + 2 * VSLOT, M_OST = M_WS + 8 * 512, M_BYTES = M_OST + 8 * 8192;
__device__ __forceinline__ void softmax_half(f32x16& p0, f32x16& p1, float& m, float& l, f32x16& o0, f32x16& o1, LAS3 float* wsf, u32x4 (&pw)[4], int hi, int r32) {
    float ra = fmaxf(fmaxf(p0[0], p0[1]), p1[0]), rb = fmaxf(fmaxf(p0[2], p0[3]), p1[1]); ra = fmaxf(fmaxf(ra, p1[2]), p1[3]);
#pragma unroll
    for (int r = 4; r < 16; r += 4) { ra = fmaxf(fmaxf(ra, p0[r]), p0[r + 1]); rb = fmaxf(fmaxf(rb, p0[r + 2]), p0[r + 3]); ra = fmaxf(fmaxf(ra, p1[r]), p1[r + 1]); rb = fmaxf(fmaxf(rb, p1[r + 2]), p1[r + 3]); }
    const float rm = swapmax(fmaxf(ra, rb));
    const float mn = fmaxf(m, rm);
    if (__any(rm > m + 8.0f)) {
        const float alpha = __builtin_amdgcn_exp2f(m - mn);
        l *= alpha; m = mn;
        if (hi == 0) wsf[r32] = alpha;
        asm volatile("s_waitcnt lgkmcnt(0)" ::: "memory");
#pragma unroll
        for (int r4 = 0; r4 < 4; ++r4) { const f32x4 al = *(const LAS3 f32x4*)(wsf + 8 * r4 + 4 * hi);
#pragma unroll
            for (int e = 0; e < 4; ++e) { o0[4 * r4 + e] *= al[e]; o1[4 * r4 + e] *= al[e]; } }
        asm volatile("s_waitcnt lgkmcnt(0)" ::: "memory");
    }
    float s0 = 0.f, s1 = 0.f;
#pragma unroll
    for (int r = 0; r < 16; ++r) { p0[r] = __builtin_amdgcn_exp2f(p0[r] - m); p1[r] = __builtin_amdgcn_exp2f(p1[r] - m); s0 += p0[r]; s1 += p1[r]; }
    l += s0 + s1;
#pragma unroll
    for (int e = 0; e < 4; ++e) { pw[0][e] = cvtpk(p0[2 * e], p0[2 * e + 1]); pw[1][e] = cvtpk(p0[8 + 2 * e], p0[8 + 2 * e + 1]);
                                  pw[2][e] = cvtpk(p1[2 * e], p1[2 * e + 1]); pw[3][e] = cvtpk(p1[8 + 2 * e], p1[8 + 2 * e + 1]); }
}
__device__ __forceinline__ void rope_q(bf16x8& q1, bf16x8& q2, const float2* rp) {
    const u32x4 x1 = __builtin_bit_cast(u32x4, q1), x2 = __builtin_bit_cast(u32x4, q2); u32x4 y1, y2;
#pragma unroll
    for (int e = 0; e < 4; ++e) { const float2 c0 = rp[2 * e], c1 = rp[2 * e + 1];
        const float a0 = bflo(x1[e]), a1 = bfhi(x1[e]), b0 = bflo(x2[e]), b1 = bfhi(x2[e]);
        y1[e] = cvtpk(a0 * c0.x - b0 * c0.y, a1 * c1.x - b1 * c1.y); y2[e] = cvtpk(a0 * c0.y + b0 * c0.x, a1 * c1.y + b1 * c1.x); }
    q1 = __builtin_bit_cast(bf16x8, y1); q2 = __builtin_bit_cast(bf16x8, y2);
}
__device__ __forceinline__ void stage_half(const f32x16& o0, const f32x16& o1, float l, LAS3 float* wsf, LAS3 bf16_t* stg, int hi, int r32) {
    l = swapsum(l);
    if (hi == 0) wsf[32 + r32] = l;
    asm volatile("s_waitcnt lgkmcnt(0)" ::: "memory");
#pragma unroll
    for (int r4 = 0; r4 < 4; ++r4) { const f32x4 lv = *(const LAS3 f32x4*)(wsf + 32 + 8 * r4 + 4 * hi);
#pragma unroll
        for (int e = 0; e < 4; ++e) { const int r = 4 * r4 + e; const float rl = __builtin_amdgcn_rcpf(lv[e]); const int orow = crow(r, hi);
            stg[orow * 64 + r32] = (bf16_t)(cvtpk(o0[r] * rl, 0.f) & 0xffffu); stg[orow * 64 + 32 + r32] = (bf16_t)(cvtpk(o1[r] * rl, 0.f) & 0xffffu); } }
}
__device__ __forceinline__ void qproc_a(bf16x8 (&q)[4], const float* g, const float2* rope, int pos_seq, int hi, float osc) {
    float x[4][8]; float ss = 0.f;
#pragma unroll
    for (int d0 = 0; d0 < 4; ++d0) { const u32x4 u = __builtin_bit_cast(u32x4, q[d0]);
#pragma unroll
        for (int e = 0; e < 4; ++e) { x[d0][2 * e] = bflo(u[e]); x[d0][2 * e + 1] = bfhi(u[e]); ss += x[d0][2 * e] * x[d0][2 * e] + x[d0][2 * e + 1] * x[d0][2 * e + 1]; } }
    ss = swapsum(ss);
    const float rstd = 1.0f / sqrtf(ss * (1.0f / 64.0f) + 1e-6f);
    const float2* rr = rope + (size_t)(pos_seq >> 6) * 16 + 8 * hi; const float2* rc = rope + (size_t)(pos_seq & 63) * 16 + 8 * hi;
#pragma unroll
    for (int d0 = 0; d0 < 4; ++d0)
#pragma unroll
        for (int e = 0; e < 8; ++e) x[d0][e] *= rstd * g[16 * d0 + 8 * hi + e];
    u32x4 y[4];
#pragma unroll
    for (int e = 0; e < 4; ++e) { float a[2], b[2], c[2], d[2];
#pragma unroll
        for (int k = 0; k < 2; ++k) { const float2 cr = rr[2 * e + k], cc = rc[2 * e + k]; const float x1 = x[0][2 * e + k], x2 = x[1][2 * e + k], z1 = x[2][2 * e + k], z2 = x[3][2 * e + k];
            a[k] = (x1 * cr.x - x2 * cr.y) * osc; b[k] = (x1 * cr.y + x2 * cr.x) * osc; c[k] = (z1 * cc.x - z2 * cc.y) * osc; d[k] = (z1 * cc.y + z2 * cc.x) * osc; }
        y[0][e] = cvtpk(a[0], a[1]); y[1][e] = cvtpk(b[0], b[1]); y[2][e] = cvtpk(c[0], c[1]); y[3][e] = cvtpk(d[0], d[1]); }
#pragma unroll
    for (int d0 = 0; d0 < 4; ++d0) q[d0] = __builtin_bit_cast(bf16x8, y[d0]);
}
__device__ __forceinline__ void softmax_rel(f32x16& p0, f32x16& p1, float& m, float& l, f32x16& o0, f32x16& o1, LAS3 float* wsf, u32x4 (&pw)[4], bool first, int hi, int r32) {
    float ra = fmaxf(fmaxf(p0[0], p0[1]), p1[0]), rb = fmaxf(fmaxf(p0[2], p0[3]), p1[1]); ra = fmaxf(fmaxf(ra, p1[2]), p1[3]);
#pragma unroll
    for (int r = 4; r < 16; r += 4) { ra = fmaxf(fmaxf(ra, p0[r]), p0[r + 1]); rb = fmaxf(fmaxf(rb, p0[r + 2]), p0[r + 3]); ra = fmaxf(fmaxf(ra, p1[r]), p1[r + 1]); rb = fmaxf(fmaxf(rb, p1[r + 2]), p1[r + 3]); }
    const float rm = swapmax(fmaxf(ra, rb));
    if (first || __any(rm > 8.0f)) {
        const float mt = m + (first ? rm : fmaxf(rm, 0.f));
        const unsigned mb = cvtpk(mt, 0.f) & 0xffffu; const float mn = __uint_as_float(mb << 16);
        const float delta = mn - m;
#pragma unroll
        for (int r = 0; r < 16; ++r) { p0[r] -= delta; p1[r] -= delta; }
        const float alpha = first ? 1.f : __builtin_amdgcn_exp2f(-delta);
        l *= alpha; m = mn;
        if (hi == 0) wsf[r32] = alpha;
        asm volatile("s_waitcnt lgkmcnt(0)" ::: "memory");
#pragma unroll
        for (int r4 = 0; r4 < 4; ++r4) { const f32x4 al = *(const LAS3 f32x4*)(wsf + 8 * r4 + 4 * hi);
#pragma unroll
            for (int e = 0; e < 4; ++e) { o0[4 * r4 + e] *= al[e]; o1[4 * r4 + e] *= al[e]; } }
        asm volatile("s_waitcnt lgkmcnt(0)" ::: "memory");
    }
    float s0 = 0.f, s1 = 0.f;
#pragma unroll
    for (int r = 0; r < 16; ++r) { p0[r] = __builtin_amdgcn_exp2f(p0[r]); p1[r] = __builtin_amdgcn_exp2f(p1[r]); s0 += p0[r]; s1 += p1[r]; }
    l += s0 + s1;
#pragma unroll
    for (int e = 0; e < 4; ++e) { pw[0][e] = cvtpk(p0[2 * e], p0[2 * e + 1]); pw[1][e] = cvtpk(p0[8 + 2 * e], p0[8 + 2 * e + 1]);
                                  pw[2][e] = cvtpk(p1[2 * e], p1[2 * e + 1]); pw[3][e] = cvtpk(p1[8 + 2 * e], p1[8 + 2 * e + 1]); }
}
template <int DQK, int MODE>
__device__ __forceinline__ void attn_unit(LAS3 unsigned char* lds, const bf16_t* aQ, const bf16_t* aK, const bf16_t* aK2, const bf16_t* aV, const bf16_t* aG, bf16_t* aO,
                                          const int a_qp, const int a_kp, const int a_k2p, const int a_vp, const int a_gp, const int a_op, const int a_q0, const int a_t_lo, const int a_t_hi,
                                          const float a_slope2, const float a_sink2, const float2* aRope, const float* aQn = nullptr) {
    constexpr int ND = DQK / 16;
    const int tid = threadIdx.x, lane = tid & 63, r32 = lane & 31, hi = lane >> 5; const int wid = __builtin_amdgcn_readfirstlane(tid >> 6);
    const int qw = a_q0 + wid * 64;
    bf16x8 qA[ND], qB[ND];
    { const bf16_t* Qw = aQ + (size_t)(qw + r32) * a_qp + hi * 8;
#pragma unroll
      for (int d0 = 0; d0 < ND; ++d0) { qA[d0] = *(const bf16x8*)(Qw + d0 * 16); qB[d0] = *(const bf16x8*)(Qw + (size_t)32 * a_qp + d0 * 16); } }
    if (DQK == 96) { rope_q(qA[ND - 2], qA[ND - 1], aRope + (size_t)(qw + r32) * 16 + 8 * hi); rope_q(qB[ND - 2], qB[ND - 1], aRope + (size_t)(qw + 32 + r32) * 16 + 8 * hi); }
    if constexpr (DQK == 64) { if (aQn) {
        qproc_a(qA, aQn, aRope, qw + r32, hi, 0.125f * 1.4426950408889634f);
#pragma unroll
        for (int d0 = 0; d0 < 4; ++d0) asm volatile("" : "+v"(qA[d0]));
        asm volatile("" ::: "memory");
        qproc_a(qB, aQn, aRope, qw + 32 + r32, hi, 0.125f * 1.4426950408889634f);
#pragma unroll
        for (int d0 = 0; d0 < 4; ++d0) asm volatile("" : "+v"(qB[d0]));
        asm volatile("" ::: "memory"); } }
    const unsigned koffg = (unsigned)(lane * a_kp + wid * 8) * 2u, k2offg = (unsigned)(lane * a_k2p + (wid & 3) * 8) * 2u, voffg = (unsigned)((16 * (wid & 3) + (lane >> 2)) * a_vp + (wid >> 2) * 32 + (lane & 3) * 8) * 2u;
    const unsigned lds0 = (unsigned)(uintptr_t)lds;
    const unsigned kdst = (unsigned)__builtin_amdgcn_readfirstlane(lds0 + M_K + wid * 1024), vdst = (unsigned)__builtin_amdgcn_readfirstlane(lds0 + M_V + wid * 1024);
    LAS3 float* wsfA = (LAS3 float*)(lds + M_WS + wid * 512); LAS3 float* wsfB = wsfA + 64;
#define AT_DMA(t, buf) do { glds16s(aK + (size_t)(t) * 64 * a_kp, koffg, kdst + (buf) * KSLOT); \
        if (DQK == 96 && wid < 4) glds16s(aK2 + (size_t)(t) * 64 * a_k2p, k2offg, kdst + (buf) * KSLOT + 8192); \
        glds16s(aV + (size_t)(t) * 64 * a_vp, voffg, vdst + (buf) * VSLOT); } while (0)
    float mA = (MODE == 1) ? a_sink2 : 0.f, mB = mA;
    float lA = (MODE == 1 && hi == 0) ? 1.f : 0.f, lB = lA;
    f32x16 oA0, oA1, oB0, oB1;
#pragma unroll
    for (int r = 0; r < 16; ++r) { oA0[r] = 0.f; oA1[r] = 0.f; oB0[r] = 0.f; oB1[r] = 0.f; }
    if (MODE == 0) {
        if (tid < 256) { const int bufi = tid >> 7, ch = (tid >> 6) & 1, row = tid & 63; const u32x4 one = {0x00003F80u, 0u, 0u, 0u}, zero = {0u, 0u, 0u, 0u};
            *(LAS3 u32x4*)(lds + M_K + bufi * KSLOT + (2 * ND + ch) * 1024 + row * 16) = ch ? zero : one; } }
    AT_DMA(a_t_lo, 0);
#pragma unroll
    for (int d0 = 0; d0 < ND; ++d0) asm volatile("" : "+v"(qA[d0]), "+v"(qB[d0]));
    asm volatile("s_waitcnt vmcnt(0)" ::: "memory"); __syncthreads();
    const int koff = hi * 1024 + r32 * 16;
    const int voff = ((lane >> 4) & 1) * 32 + (lane & 3) * 8 + (4 * hi + ((lane & 15) >> 2)) * 64;
    for (int t = a_t_lo; t < a_t_hi; ++t) {
        const int cur = (t - a_t_lo) & 1;
        if (t + 1 < a_t_hi) AT_DMA(t + 1, cur ^ 1);
        bool active = true;
        if (MODE == 1) { const int k0 = t * 64; active = (k0 + 63 >= qw - 128) && (k0 <= qw + 63 + 128); }
        if (active) {
            f32x16 pA0, pA1, pB0, pB1;
#pragma unroll
            for (int r = 0; r < 16; ++r) { pA0[r] = 0.f; pA1[r] = 0.f; pB0[r] = 0.f; pB1[r] = 0.f; }
            const LAS3 char* kb = (const LAS3 char*)(lds + M_K + cur * KSLOT + koff);
#pragma unroll
            for (int d0 = 0; d0 < ND; ++d0) {
                const bf16x8 b0 = *(const LAS3 bf16x8*)(kb + d0 * 2048), b1 = *(const LAS3 bf16x8*)(kb + d0 * 2048 + 512);
                pA0 = __builtin_amdgcn_mfma_f32_32x32x16_bf16(b0, qA[d0], pA0, 0, 0, 0);
                pA1 = __builtin_amdgcn_mfma_f32_32x32x16_bf16(b1, qA[d0], pA1, 0, 0, 0);
                pB0 = __builtin_amdgcn_mfma_f32_32x32x16_bf16(b0, qB[d0], pB0, 0, 0, 0);
                pB1 = __builtin_amdgcn_mfma_f32_32x32x16_bf16(b1, qB[d0], pB1, 0, 0, 0);
            }
            if (MODE == 0) {
                const bf16x8 b0 = *(const LAS3 bf16x8*)(kb + ND * 2048), b1 = *(const LAS3 bf16x8*)(kb + ND * 2048 + 512);
                const u32x4 qxA = {hi == 0 ? (__float_as_uint(-mA) >> 16) : 0u, 0u, 0u, 0u}, qxB = {hi == 0 ? (__float_as_uint(-mB) >> 16) : 0u, 0u, 0u, 0u};
                const bf16x8 fa = __builtin_bit_cast(bf16x8, qxA), fb = __builtin_bit_cast(bf16x8, qxB);
                pA0 = __builtin_amdgcn_mfma_f32_32x32x16_bf16(b0, fa, pA0, 0, 0, 0); pA1 = __builtin_amdgcn_mfma_f32_32x32x16_bf16(b1, fa, pA1, 0, 0, 0);
                pB0 = __builtin_amdgcn_mfma_f32_32x32x16_bf16(b0, fb, pB0, 0, 0, 0); pB1 = __builtin_amdgcn_mfma_f32_32x32x16_bf16(b1, fb, pB1, 0, 0, 0);
            }
            if (MODE == 1) { const int rel0 = t * 64 + 4 * hi - (qw + r32);
#pragma unroll
                for (int r = 0; r < 16; ++r) { const int d = rel0 + (r & 3) + 8 * (r >> 2);
                    const int a0 = d < 0 ? -d : d, a1 = (d + 32) < 0 ? -(d + 32) : (d + 32), a2 = (d - 32) < 0 ? -(d - 32) : (d - 32);
                    pA0[r] = (a0 <= 128) ? pA0[r] - a_slope2 * (float)a0 : -INFINITY; pA1[r] = (a1 <= 128) ? pA1[r] - a_slope2 * (float)a1 : -INFINITY;
                    pB0[r] = (a2 <= 128) ? pB0[r] - a_slope2 * (float)a2 : -INFINITY; pB1[r] = (a0 <= 128) ? pB1[r] - a_slope2 * (float)a0 : -INFINITY; } }
            u32x4 pwA[4], pwB[4];
            if (MODE == 0) { softmax_rel(pA0, pA1, mA, lA, oA0, oA1, wsfA, pwA, t == a_t_lo, hi, r32); softmax_rel(pB0, pB1, mB, lB, oB0, oB1, wsfB, pwB, t == a_t_lo, hi, r32); }
            else { softmax_half(pA0, pA1, mA, lA, oA0, oA1, wsfA, pwA, hi, r32); softmax_half(pB0, pB1, mB, lB, oB0, oB1, wsfB, pwB, hi, r32); }
            const LAS3 char* vb = (const LAS3 char*)(lds + M_V + cur * VSLOT + voff);
#pragma unroll
            for (int ks = 0; ks < 4; ++ks) {
                const s16x4 a0 = vtr(vb + ks * 1024), a1 = vtr(vb + ks * 1024 + 512), c0 = vtr(vb + 4096 + ks * 1024), c1 = vtr(vb + 4096 + ks * 1024 + 512);
                const bf16x8 v0 = {a0[0], a0[1], a0[2], a0[3], a1[0], a1[1], a1[2], a1[3]}, v1 = {c0[0], c0[1], c0[2], c0[3], c1[0], c1[1], c1[2], c1[3]};
                const bf16x8 pa = __builtin_bit_cast(bf16x8, pwA[ks]), pb = __builtin_bit_cast(bf16x8, pwB[ks]);
                oA0 = __builtin_amdgcn_mfma_f32_32x32x16_bf16(pa, v0, oA0, 0, 0, 0);
                oA1 = __builtin_amdgcn_mfma_f32_32x32x16_bf16(pa, v1, oA1, 0, 0, 0);
                oB0 = __builtin_amdgcn_mfma_f32_32x32x16_bf16(pb, v0, oB0, 0, 0, 0);
                oB1 = __builtin_amdgcn_mfma_f32_32x32x16_bf16(pb, v1, oB1, 0, 0, 0);
            }
        }
        asm volatile("s_waitcnt vmcnt(0)" ::: "memory"); __syncthreads();
    }
    LAS3 bf16_t* stg = (LAS3 bf16_t*)(lds + M_OST + wid * 8192);
    stage_half(oA0, oA1, lA, wsfA, stg, hi, r32);
    stage_half(oB0, oB1, lB, wsfB, stg + 32 * 64, hi, r32);
    asm volatile("s_waitcnt lgkmcnt(0)" ::: "memory");
#pragma unroll
    for (int i = 0; i < 8; ++i) { const int row = i * 8 + (lane >> 3), ch = lane & 7;
        const u32x4 ov = *(const LAS3 u32x4*)(stg + row * 64 + ch * 8);
        const u32x4 gv = *(const u32x4*)(aG + (size_t)(qw + row) * a_gp + ch * 8);
        u32x4 w;
#pragma unroll
        for (int e = 0; e < 4; ++e) w[e] = cvtpk(bflo(ov[e]) * silu_f(bflo(gv[e])), bfhi(ov[e]) * silu_f(bfhi(gv[e])));
        *(u32x4*)(aO + (size_t)(qw + row) * a_op + ch * 8) = w; }
    asm volatile("s_waitcnt lgkmcnt(0)" ::: "memory");
#undef AT_DMA
}
}
namespace att6 {
using namespace att;
constexpr int TSLOT = 16384;
constexpr int X_R = 0, X_WS = 5 * TSLOT, X_OST = X_WS + 8 * 512, X_BYTES = X_OST + 8 * 4096;
__device__ __forceinline__ void attn_unit_win(LAS3 unsigned char* lds, const bf16_t* aQ, const bf16_t* aK, const bf16_t* aV, const bf16_t* aG, bf16_t* aO,
                                              const int pitch, const int a_op, const int a_q0, const int tile0  , const int ntiles_seq,
                                              const float slopeA, const float sinkA, const float slopeB, const float sinkB) {
    const int tid = threadIdx.x, lane = tid & 63, r32 = lane & 31, hi = lane >> 5; const int wid = __builtin_amdgcn_readfirstlane(tid >> 6);
    const int qw = a_q0 + wid * 32;
    const unsigned koffg = (unsigned)(lane * pitch + wid * 8) * 2u, voffg = (unsigned)((16 * (wid & 3) + (lane >> 2)) * pitch + (wid >> 2) * 32 + (lane & 3) * 8) * 2u;
    const unsigned lds0 = (unsigned)(uintptr_t)lds;
    const unsigned kdst = (unsigned)__builtin_amdgcn_readfirstlane(lds0 + X_R + wid * 1024), vdst = kdst + 8192u;
#define A6_DMA(j) do { int tt_ = tile0 + (j); tt_ = tt_ < 0 ? 0 : (tt_ >= ntiles_seq ? ntiles_seq - 1 : tt_); const unsigned so_ = (unsigned)(((j) % 5) * TSLOT); \
        glds16s(aK + (size_t)tt_ * 64 * pitch, koffg, kdst + so_); glds16s(aV + (size_t)tt_ * 64 * pitch, voffg, vdst + so_); } while (0)
    A6_DMA(0); A6_DMA(1); A6_DMA(2); A6_DMA(3);
    bf16x8 qA[4], qB[4];
    { const bf16_t* Qw = aQ + (size_t)(qw + r32) * pitch + hi * 8;
#pragma unroll
      for (int d0 = 0; d0 < 4; ++d0) { qA[d0] = *(const bf16x8*)(Qw + d0 * 16); qB[d0] = *(const bf16x8*)(Qw + 64 + d0 * 16); } }
#pragma unroll
    for (int d0 = 0; d0 < 4; ++d0) asm volatile("" : "+v"(qA[d0]), "+v"(qB[d0]));
    LAS3 float* wsfA = (LAS3 float*)(lds + X_WS + wid * 512); LAS3 float* wsfB = wsfA + 64;
    float mA = sinkA, mB = sinkB, lA = (hi == 0) ? 1.f : 0.f, lB = lA;
    f32x16 oA0, oA1, oB0, oB1;
#pragma unroll
    for (int r = 0; r < 16; ++r) { oA0[r] = 0.f; oA1[r] = 0.f; oB0[r] = 0.f; oB1[r] = 0.f; }
    const int koff = hi * 1024 + r32 * 16;
    const int voff = 8192 + ((lane >> 4) & 1) * 32 + (lane & 3) * 8 + (4 * hi + ((lane & 15) >> 2)) * 64;
    asm volatile("s_waitcnt vmcnt(0) lgkmcnt(0)\n\ts_barrier" ::: "memory");
#pragma unroll 1
    for (int s = 0; s < 5; ++s) {
        if (s < 4) { int tt_ = tile0 + s + 4; tt_ = tt_ < 0 ? 0 : (tt_ >= ntiles_seq ? ntiles_seq - 1 : tt_); const unsigned so_ = (unsigned)((s == 0 ? 4 : s - 1) * TSLOT);
            glds16s(aK + (size_t)tt_ * 64 * pitch, koffg, kdst + so_); glds16s(aV + (size_t)tt_ * 64 * pitch, voffg, vdst + so_); }
        const int j = (wid >> 1) + s;
        const int t = tile0 + j; const int k0 = t * 64;
        const int slot = (j >= 5 ? j - 5 : j) * TSLOT;
        if (t >= 0 && t < ntiles_seq) {
            f32x16 pA0, pA1, pB0, pB1;
#pragma unroll
            for (int r = 0; r < 16; ++r) { pA0[r] = 0.f; pA1[r] = 0.f; pB0[r] = 0.f; pB1[r] = 0.f; }
            const LAS3 char* kb = (const LAS3 char*)(lds + X_R + slot + koff);
#pragma unroll
            for (int d0 = 0; d0 < 4; ++d0) {
                const bf16x8 b0 = *(const LAS3 bf16x8*)(kb + d0 * 2048), b1 = *(const LAS3 bf16x8*)(kb + d0 * 2048 + 512);
                pA0 = __builtin_amdgcn_mfma_f32_32x32x16_bf16(b0, qA[d0], pA0, 0, 0, 0); pA1 = __builtin_amdgcn_mfma_f32_32x32x16_bf16(b1, qA[d0], pA1, 0, 0, 0);
                pB0 = __builtin_amdgcn_mfma_f32_32x32x16_bf16(b0, qB[d0], pB0, 0, 0, 0); pB1 = __builtin_amdgcn_mfma_f32_32x32x16_bf16(b1, qB[d0], pB1, 0, 0, 0);
            }
            { const float fd0 = (float)(k0 + 4 * hi - (qw + r32));
#pragma unroll
              for (int r = 0; r < 16; ++r) { const float t0 = fd0 + (float)((r & 3) + 8 * (r >> 2)), t1 = t0 + 32.f;
                  pA0[r] = __builtin_fmaf(-slopeA, __builtin_fabsf(t0), pA0[r]); pA1[r] = __builtin_fmaf(-slopeA, __builtin_fabsf(t1), pA1[r]);
                  pB0[r] = __builtin_fmaf(-slopeB, __builtin_fabsf(t0), pB0[r]); pB1[r] = __builtin_fmaf(-slopeB, __builtin_fabsf(t1), pB1[r]);
                  if (s == 0 || s == 4) { const bool in0 = __builtin_fabsf(t0) <= 128.f, in1 = __builtin_fabsf(t1) <= 128.f;
                      pA0[r] = in0 ? pA0[r] : -INFINITY; pA1[r] = in1 ? pA1[r] : -INFINITY; pB0[r] = in0 ? pB0[r] : -INFINITY; pB1[r] = in1 ? pB1[r] : -INFINITY; } } }
            u32x4 pwA[4], pwB[4];
            att2::softmax_half(pA0, pA1, mA, lA, oA0, oA1, wsfA, pwA, hi, r32);
            att2::softmax_half(pB0, pB1, mB, lB, oB0, oB1, wsfB, pwB, hi, r32);
            const LAS3 char* vb = (const LAS3 char*)(lds + X_R + slot + voff);
#pragma unroll
            for (int ks = 0; ks < 4; ++ks) {
                const s16x4 a0 = vtr(vb + ks * 1024), a1 = vtr(vb + ks * 1024 + 512), c0 = vtr(vb + 4096 + ks * 1024), c1 = vtr(vb + 4096 + ks * 1024 + 512);
                const bf16x8 v0 = {a0[0], a0[1], a0[2], a0[3], a1[0], a1[1], a1[2], a1[3]}, v1 = {c0[0], c0[1], c0[2], c0[3], c1[0], c1[1], c1[2], c1[3]};
                const bf16x8 pa = __builtin_bit_cast(bf16x8, pwA[ks]), pb = __builtin_bit_cast(bf16x8, pwB[ks]);
                oA0 = __builtin_amdgcn_mfma_f32_32x32x16_bf16(pa, v0, oA0, 0, 0, 0); oA1 = __builtin_amdgcn_mfma_f32_32x32x16_bf16(pa, v1, oA1, 0, 0, 0);
                oB0 = __builtin_amdgcn_mfma_f32_32x32x16_bf16(pb, v0, oB0, 0, 0, 0); oB1 = __builtin_amdgcn_mfma_f32_32x32x16_bf16(pb, v1, oB1, 0, 0, 0);
            }
        }
        asm volatile("s_waitcnt vmcnt(0) lgkmcnt(0)\n\ts_barrier" ::: "memory");
    }
    LAS3 bf16_t* stg = (LAS3 bf16_t*)(lds + X_OST + wid * 4096);
#pragma unroll
    for (int hd = 0; hd < 2; ++hd) {
        if (hd == 0) att2::stage_half(oA0, oA1, lA, wsfA, stg, hi, r32); else att2::stage_half(oB0, oB1, lB, wsfB, stg, hi, r32);
        asm volatile("s_waitcnt lgkmcnt(0)" ::: "memory");
#pragma unroll
        for (int i = 0; i < 4; ++i) { const int row = i * 8 + (lane >> 3), ch = lane & 7;
            const u32x4 ov = *(const LAS3 u32x4*)(stg + row * 64 + ch * 8);
            const u32x4 gv = *(const u32x4*)(aG + (size_t)(qw + row) * pitch + hd * 64 + ch * 8);
            u32x4 w;
#pragma unroll
            for (int e = 0; e < 4; ++e) w[e] = cvtpk(bflo(ov[e]) * silu_f(bflo(gv[e])), bfhi(ov[e]) * silu_f(bfhi(gv[e])));
            *(u32x4*)(aO + (size_t)(qw + row) * a_op + hd * 64 + ch * 8) = w; }
        asm volatile("s_waitcnt vmcnt(0) lgkmcnt(0)" ::: "memory");
    }
#undef A6_DMA
}
}
#define GAS __attribute__((address_space(1)))
#define LAS __attribute__((address_space(3)))
typedef unsigned short bf16;
typedef unsigned v4u __attribute__((ext_vector_type(4)));
typedef unsigned v2u __attribute__((ext_vector_type(2)));
typedef float f32x4 __attribute__((ext_vector_type(4)));
constexpr int DM = 1024, NBATCH = 4, SEQ = 4096, TOK = NBATCH * SEQ;
constexpr int N0 = 2304, N0_REAL = 2208, N1 = 2560;
constexpr int C_QA = 0, C_KA = 512, C_VA = 640, C_GA = 768, C_CQ = 1280, C_CKV = 1536, C_KR = 1664, C_GB = 1696;
constexpr int C_QC = 0, C_KC = 1024, C_VC = 1280, C_GC = 1536;
constexpr float EPS = 1e-6f, LOG2E = 1.4426950408889634f;
constexpr float C2A = 0.125f * LOG2E;
constexpr float C2B = 0.10206207261596577f * LOG2E;
constexpr size_t MiB = 1u << 20;
constexpr size_t WS_CTL = 0, CTL_ZERO_BYTES = 49152;
constexpr size_t WS_CNT6 = 16384, WS_CNT10 = 32768, WS_XB6 = 256 * 1024, WS_XB10 = 512 * 1024;
constexpr size_t WS_MOD = 1 * MiB, WS_ROPE = 1 * MiB + 256 * 1024;
constexpr size_t WS_WIN0 = 2 * MiB, WS_WOUT0 = 7 * MiB, WS_WIN1 = 9 * MiB, WS_WOUT1 = 14 * MiB, WS_WUQ = 16 * MiB, WS_WUKV = 16 * MiB + 512 * 1024;
constexpr size_t WS_H = 32 * MiB, WS_P = 64 * MiB, WS_QB = 144 * MiB, WS_KVB = 168 * MiB, WS_MIX = 200 * MiB, WS_CQN = 232 * MiB, WS_CKVN = 240 * MiB, WS_END = 244 * MiB;
constexpr int LDS_BYTES = 147456;
static_assert(att2::M_BYTES <= 131072 && att6::X_BYTES <= LDS_BYTES - 64, "attention LDS");

struct Params {
    const float *x, *c, *norm_w, *ada_w, *ada_b, *even_w_in, *a_q_norm, *a_k_norm, *b_q_lora_norm, *b_kv_lora_norm, *b_w_uq, *b_w_uk, *b_w_uv, *even_w_out, *odd_w_in, *c_sink, *odd_w_out, *final_norm;
    float* out; unsigned char* ws;
};

__device__ __forceinline__ unsigned f2bf(float f) { unsigned u = __builtin_bit_cast(unsigned, f); return (u + 0x7fffu + ((u >> 16) & 1u)) >> 16; }
__device__ __forceinline__ unsigned pk2(float lo, float hi) { return f2bf(lo) | (f2bf(hi) << 16); }
__device__ __forceinline__ float bflo(unsigned u) { return __uint_as_float(u << 16); }
__device__ __forceinline__ float bfhi(unsigned u) { return __uint_as_float(u & 0xffff0000u); }
__device__ __forceinline__ float wave_sum(float v) {
#pragma unroll
    for (int o = 1; o < 64; o <<= 1) v += __shfl_xor(v, o);
    return v;
}
#define LDS_WAIT() asm volatile("s_waitcnt lgkmcnt(0)" ::: "memory")

__device__ __forceinline__ void transpose_item(const float* W, int K, int N, bf16* WT, int row_off, LAS float* scr, int item, int lane) {
    const int nblk = N / 32, kb = item / nblk, nb = item % nblk, k0 = 64 * kb, n0 = 32 * nb;
#pragma unroll 8
    for (int i = 0; i < 32; ++i) { const int kk = 2 * i + (lane >> 5); scr[kk * 33 + (lane & 31)] = W[(size_t)(k0 + kk) * N + n0 + (lane & 31)]; }
    LDS_WAIT(); asm volatile("" ::: "memory");
    const int c = lane & 7;
#pragma unroll
    for (int j = 0; j < 4; ++j) { const int n = (lane >> 3) + 8 * j; const LAS float* s = scr + (8 * c) * 33 + n;
        v4u o; o.x = pk2(s[0 * 33], s[1 * 33]); o.y = pk2(s[2 * 33], s[3 * 33]); o.z = pk2(s[4 * 33], s[5 * 33]); o.w = pk2(s[6 * 33], s[7 * 33]);
        *(v4u*)(WT + (size_t)(row_off + n0 + n) * K + k0 + 8 * c) = o; }
    LDS_WAIT(); asm volatile("" ::: "memory");
}

__device__ __forceinline__ void adaln_rows(const float* xin, const float* nw, const float* mod  , bf16* H, int gw, int NGW, int lane) {
    constexpr int NR = 4;
    for (int mb = gw; mb < TOK; mb += NR * NGW) {
        f32x4 v[NR][4]; float ss[NR]; int mr[NR];
#pragma unroll
        for (int r = 0; r < NR; ++r) { const int m = mb + r * NGW; mr[r] = m < TOK ? m : mb; const f32x4* xr = (const f32x4*)(xin + (size_t)mr[r] * DM) + lane;
#pragma unroll
            for (int j = 0; j < 4; ++j) v[r][j] = xr[64 * j]; }
#pragma unroll
        for (int r = 0; r < NR; ++r) { float s = 0.f;
#pragma unroll
            for (int j = 0; j < 4; ++j) s += (v[r][j].x * v[r][j].x + v[r][j].y * v[r][j].y) + (v[r][j].z * v[r][j].z + v[r][j].w * v[r][j].w);
            ss[r] = 1.f / sqrtf(wave_sum(s) * (1.f / DM) + EPS); }
#pragma unroll
        for (int j = 0; j < 4; ++j) { const int cidx = 4 * (lane + 64 * j); const f32x4 w = *(const f32x4*)(nw + cidx);
#pragma unroll
            for (int r = 0; r < NR; ++r) { if (r > 0 && mb + r * NGW >= TOK) continue; const float* mbp = mod + (size_t)(mr[r] >> 12) * 3072;
                const f32x4 sh = *(const f32x4*)(mbp + cidx), sc = *(const f32x4*)(mbp + 1024 + cidx); const f32x4 h = v[r][j] * ss[r] * w * (sc + 1.f) + sh;
                v2u o; o.x = pk2(h.x, h.y); o.y = pk2(h.z, h.w); *(v2u*)(H + (size_t)mr[r] * DM + cidx) = o; } }
    }
}

struct PostRaw { v4u k; v2u cq; unsigned ckv; unsigned r1, r2; float2 cs[8]; float2 ckr; };
__device__ __forceinline__ void post_load(PostRaw& R, const bf16* pr, int m, const float2* rope, int lane) {
    R.k = *(const v4u*)(pr + C_KA + 8 * (lane & 15)); R.cq = *(const v2u*)(pr + C_CQ + 4 * lane); R.ckv = *(const unsigned*)(pr + C_CKV + 2 * lane);
    R.r1 = pr[C_KR + (lane & 15)]; R.r2 = pr[C_KR + 16 + (lane & 15)];
    const int j = lane & 7, s = m & 4095; const float2* rp = rope + (size_t)((j < 4) ? (s >> 6) : (s & 63)) * 16 + 8 * (j & 1);
#pragma unroll
    for (int e = 0; e < 8; ++e) R.cs[e] = rp[e];
    R.ckr = rope[(size_t)s * 16 + (lane & 15)];
}
__device__ __forceinline__ v4u post_head(const v4u raw, const float* g8, const float2 (&rp)[8], int j, float osc) {
    float xv[8];
#pragma unroll
    for (int e = 0; e < 4; ++e) { xv[2 * e] = bflo(raw[e]); xv[2 * e + 1] = bfhi(raw[e]); }
    float ss = 0.f;
#pragma unroll
    for (int e = 0; e < 8; ++e) ss += xv[e] * xv[e];
    ss += __shfl_xor(ss, 1); ss += __shfl_xor(ss, 2); ss += __shfl_xor(ss, 4);
    const float rstd = 1.f / sqrtf(ss * (1.f / 64.f) + EPS);
    float y[8];
#pragma unroll
    for (int e = 0; e < 8; ++e) { const float xn = xv[e] * rstd * g8[e]; const float pt = __shfl_xor(xn, 2); const float2 cs = rp[e];
        y[e] = ((j & 2) == 0 ? xn * cs.x - pt * cs.y : pt * cs.y + xn * cs.x) * osc; }
    v4u o; o.x = pk2(y[0], y[1]); o.y = pk2(y[2], y[3]); o.z = pk2(y[4], y[5]); o.w = pk2(y[6], y[7]); return o;
}
__device__ __forceinline__ void post_compute(const PostRaw& R, int m, bf16* pr, const float* a_q_norm, const float* a_k_norm, const float* b_q_lora_norm, const float* b_kv_lora_norm,
                                             bf16* CQN, bf16* CKVN, const float2* rope, int lane) {
    const int j = lane & 7;
    const v4u ok = post_head(R.k, a_k_norm + 8 * j, R.cs, j, 1.f);
    if (lane < 16) *(v4u*)(pr + C_KA + 8 * lane) = ok;
    {
        const float a0 = bflo(R.cq.x), a1 = bfhi(R.cq.x), a2 = bflo(R.cq.y), a3 = bfhi(R.cq.y);
        const float rstd = 1.f / sqrtf(wave_sum((a0 * a0 + a1 * a1) + (a2 * a2 + a3 * a3)) * (1.f / 256.f) + EPS);
        const f32x4 g = *(const f32x4*)(b_q_lora_norm + 4 * lane);
        v2u o; o.x = pk2(a0 * rstd * g.x, a1 * rstd * g.y); o.y = pk2(a2 * rstd * g.z, a3 * rstd * g.w); *(v2u*)(CQN + (size_t)m * 256 + 4 * lane) = o;
    }
    {
        const float a0 = bflo(R.ckv), a1 = bfhi(R.ckv);
        const float rstd = 1.f / sqrtf(wave_sum(a0 * a0 + a1 * a1) * (1.f / 128.f) + EPS);
        const float2 g = *(const float2*)(b_kv_lora_norm + 2 * lane);
        *(unsigned*)(CKVN + (size_t)m * 128 + 2 * lane) = pk2(a0 * rstd * g.x, a1 * rstd * g.y);
    }
    if (lane < 16) {
        const float x1 = __uint_as_float(R.r1 << 16), x2 = __uint_as_float(R.r2 << 16);
        const float2 cs = R.ckr;
        pr[C_KR + lane] = (bf16)f2bf(x1 * cs.x - x2 * cs.y); pr[C_KR + 16 + lane] = (bf16)f2bf(x1 * cs.y + x2 * cs.x);
    }
}
__device__ __forceinline__ void post_rows(const float* a_q_norm, const float* a_k_norm, const float* b_q_lora_norm, const float* b_kv_lora_norm, bf16* P, bf16* CQN, bf16* CKVN, const float2* rope, int gw, int NGW, int lane) {
    constexpr int NR = 4;
    for (int mb = gw; mb < TOK; mb += NR * NGW) {
        PostRaw R[NR];
#pragma unroll
        for (int r = 0; r < NR; ++r) { const int m = mb + r * NGW; post_load(R[r], P + (size_t)(m < TOK ? m : mb) * N0, m < TOK ? m : mb, rope, lane); }
#pragma unroll
        for (int r = 0; r < NR; ++r) { const int m = mb + r * NGW; if (m < TOK) post_compute(R[r], m, P + (size_t)m * N0, a_q_norm, a_k_norm, b_q_lora_norm, b_kv_lora_norm, CQN, CKVN, rope, lane); }
    }
}
typedef unsigned v4u_xb;
#define RLX_AGENT __ATOMIC_RELAXED, __HIP_MEMORY_SCOPE_AGENT
#define XB_TMO      128
#define XB_XCNT(j)  (256  + 64 * (j))
#define XB_XSUB(j)  (1280 + 64 * (j))
#define XB_XGEN(j)  (2304 + 64 * (j))
#define XB_TOP      3328
#define XB_TOPGEN   3392
#define XCD_BAR_WORDS 3456
#define XB_SPIN_CAP (1u << 18)

__device__ __forceinline__ unsigned xb_ld(unsigned* p)              { return __hip_atomic_load(p, __ATOMIC_RELAXED, __HIP_MEMORY_SCOPE_AGENT); }
__device__ __forceinline__ unsigned xb_add(unsigned* p, unsigned v) { return __hip_atomic_fetch_add(p, v, __ATOMIC_RELAXED, __HIP_MEMORY_SCOPE_AGENT); }
__device__ __forceinline__ unsigned xb_xcc_id() { return (unsigned)__builtin_amdgcn_s_getreg((3 << 11) | 20) & 0xFu; }
#define XB_SPIN(cond, bar) do { unsigned _sp = 0; while (cond) { __builtin_amdgcn_s_sleep(1); \
    if ((++_sp & 255u) == 0u) { if (xb_ld(&(bar)[XB_TMO])) break; if (_sp > XB_SPIN_CAP) { atomicAdd(&(bar)[XB_TMO], 1u); break; } } } } while (0)

struct XcdBarrier {
    unsigned* bar; unsigned x;
    volatile LAS unsigned* st;
};
__device__ __forceinline__ XcdBarrier xcd_barrier_post(unsigned* bar, volatile LAS unsigned* st) {
    XcdBarrier b; b.bar = bar; b.x = xb_xcc_id(); b.st = st;
    if (threadIdx.x == 0) (void)xb_add(&bar[XB_XCNT(b.x)], 1u);
    return b;
}
__device__ __forceinline__ void xcd_barrier_complete(unsigned* bar, unsigned x, unsigned& nloc, unsigned& nx) {
    const unsigned G = gridDim.x * gridDim.y * gridDim.z;
    unsigned sum, cnt, mine, sp = 0u;
    for (;;) {
        sum = 0u; cnt = 0u; mine = 0u;
#pragma unroll
        for (unsigned j = 0; j < 16; ++j) { const unsigned c = xb_ld(&bar[XB_XCNT(j)]); sum += c; cnt += (c > 0u) ? 1u : 0u; mine = (j == x) ? c : mine; }
        if (sum == G) break;
        __builtin_amdgcn_s_sleep(1);
        if ((++sp & 255u) == 0u) { if (xb_ld(&bar[XB_TMO])) break; if (sp > XB_SPIN_CAP) { atomicAdd(&bar[XB_TMO], 1u); break; } }
    }
    nloc = mine > 0u ? mine : 1u; nx = cnt > 0u ? cnt : 1u;
}

__device__ __forceinline__ void xcd_barrier(const XcdBarrier& b) {
    asm volatile("s_waitcnt vmcnt(0)" ::: "memory");
    __syncthreads();
    if (threadIdx.x == 0) {
        unsigned* bar = b.bar;
        __builtin_amdgcn_s_waitcnt(0);
        unsigned nloc = b.st[0], nx = b.st[1];
        if (nloc == 0u) { xcd_barrier_complete(bar, b.x, nloc, nx); b.st[0] = nloc; b.st[1] = nx; }
        const unsigned old = xb_add(&bar[XB_XSUB(b.x)], 1u);
        const unsigned gen = old / nloc;
        if (old + 1u == (gen + 1u) * nloc) {
            __builtin_amdgcn_fence(__ATOMIC_RELEASE, "agent");
            asm volatile("s_waitcnt vmcnt(0)" ::: "memory");
            const unsigned og = xb_add(&bar[XB_TOP], 1u);
            const unsigned tg = og / nx;
            if (og + 1u == (tg + 1u) * nx) xb_add(&bar[XB_TOPGEN], 1u);
            else XB_SPIN(xb_ld(&bar[XB_TOPGEN]) == tg, bar);
            __builtin_amdgcn_fence(__ATOMIC_ACQUIRE, "agent");
            xb_add(&bar[XB_XGEN(b.x)], 1u);
            asm volatile("s_waitcnt vmcnt(0)" ::: "memory");
        } else {
            XB_SPIN(xb_ld(&bar[XB_XGEN(b.x)]) == gen, bar);
            __builtin_amdgcn_fence(__ATOMIC_ACQUIRE, "agent");
            asm volatile("s_waitcnt vmcnt(0)" ::: "memory");
        }
    }
    __syncthreads();
}

__device__ __forceinline__ void rope_table(float2* R, int widx, int NW, int tid) {
    for (int i = widx * 512 + tid; i < 4096 * 16; i += NW * 512) { const int pos = i >> 4, fi = i & 15; const float inv = powf(10000.0f, -(float)fi * (1.0f / 16.0f)); const float ang = (float)pos * inv;
        R[i] = make_float2((float)cos((double)ang), (float)sin((double)ang)); }
}
constexpr int NPHASE = 12;
__global__ void __launch_bounds__(512, 2) mega_fwd(Params p, int ph_lo, int ph_hi) {
    extern __shared__ __attribute__((aligned(16))) unsigned char lds_raw[];
    LAS unsigned char* lds = (LAS unsigned char*)lds_raw;
    cg::grid_group grid = cg::this_grid();
    const int tid = threadIdx.x, lane = tid & 63, wave = __builtin_amdgcn_readfirstlane(tid >> 6);
    const int G = gridDim.x, bx = blockIdx.x;
    const int vcu = (G % 8 == 0) ? (bx % 8) * (G / 8) + bx / 8 : bx;
    const int gw = vcu * 8 + wave, NGW = G * 8;
    const bool rebal = (G == 256);
    const bool fuse_norm = (G == 256) && (ph_hi - ph_lo == NPHASE);
    typedef const __attribute__((address_space(4))) Params* KPtr;
#define KP_LOAD() KPtr kp = (KPtr)__builtin_amdgcn_kernarg_segment_ptr(); asm volatile("" : "+s"(kp)); unsigned char* ws = kp->ws; (void)ws
#define MOD ((float*)(ws + WS_MOD))
#define ROPE ((const float2*)(ws + WS_ROPE))
#define WIN0 ((bf16*)(ws + WS_WIN0))
#define WOUT0 ((bf16*)(ws + WS_WOUT0))
#define WIN1 ((bf16*)(ws + WS_WIN1))
#define WOUT1 ((bf16*)(ws + WS_WOUT1))
#define WUQ ((bf16*)(ws + WS_WUQ))
#define WUKV ((bf16*)(ws + WS_WUKV))
#define H ((bf16*)(ws + WS_H))
#define P ((bf16*)(ws + WS_P))
#define QB ((bf16*)(ws + WS_QB))
#define KVB ((bf16*)(ws + WS_KVB))
#define MIX ((bf16*)(ws + WS_MIX))
#define CQN ((bf16*)(ws + WS_CQN))
#define CKVN ((bf16*)(ws + WS_CKVN))
#ifndef PH_MASK
#define PH_MASK 0xfff
#endif
#define IN(k) (((PH_MASK >> (k)) & 1) && ph_lo <= (k) && (k) < ph_hi)
    volatile LAS unsigned* xb_st = (volatile LAS unsigned*)(lds + LDS_BYTES - 64);
    if (tid < 16) xb_st[tid] = 0u;
    __syncthreads();
    XcdBarrier xbar = xcd_barrier_post((unsigned*)(p.ws + WS_CTL), xb_st);
    if (ph_hi - ph_lo > 1) grid.sync();
#define SEAM(k) do { if (IN(k) && IN((k) + 1)) xcd_barrier(xbar); } while (0)

    if (IN(0)) { KP_LOAD();
        LAS float* scr = (LAS float*)(lds + wave * 16384);
        if (rebal) {
            if (vcu < 192) {
                LAS float* red = (LAS float*)(lds + 131072);
                const int l = vcu / 96, rem = vcu % 96, kh = rem & 1, kb = kh * 512 + wave * 64, jc = (rem >> 1) * 64 + lane;
                for (int i = lane; i < 256; i += 64) { const float cv = kp->c[(i >> 6) * DM + kb + (i & 63)]; scr[i] = cv / (1.f + __expf(-cv)); }
                LDS_WAIT(); asm volatile("" ::: "memory");
                const float* w = kp->ada_w + (size_t)l * DM * 3072 + (size_t)kb * 3072 + jc;
                float a0 = 0.f, a1 = 0.f, a2 = 0.f, a3 = 0.f;
#pragma unroll 16
                for (int i = 0; i < 64; ++i) { const float wv = w[(size_t)i * 3072]; a0 += scr[i] * wv; a1 += scr[64 + i] * wv; a2 += scr[128 + i] * wv; a3 += scr[192 + i] * wv; }
                red[(wave * 4 + 0) * 64 + lane] = a0; red[(wave * 4 + 1) * 64 + lane] = a1; red[(wave * 4 + 2) * 64 + lane] = a2; red[(wave * 4 + 3) * 64 + lane] = a3;
                __syncthreads();
                if (wave < 4) { float sum = kh == 0 ? kp->ada_b[l * 3072 + jc] : 0.f;
#pragma unroll
                    for (int w8 = 0; w8 < 8; ++w8) sum += red[(w8 * 4 + wave) * 64 + lane];
                    __hip_atomic_fetch_add((float*)(ws + WS_MOD) + (size_t)l * 4 * 3072 + (size_t)wave * 3072 + jc, sum, __ATOMIC_RELAXED, __HIP_MEMORY_SCOPE_AGENT); }
            } else {
                const int w0 = (vcu - 192) * 8 + wave, nw0 = (G - 192) * 8; constexpr int I4 = 4 * 24, I5 = 2 * 16, I6 = 2 * 16;
                for (int it = w0; it < I4 + I5 + I6; it += nw0) { int r = it;
                    if (r < I4) { transpose_item(kp->b_w_uq, 256, 768, WUQ, 0, scr, r, lane); continue; } r -= I4;
                    if (r < I5) { transpose_item(kp->b_w_uk, 128, 512, WUKV, 0, scr, r, lane); continue; } r -= I5;
                    transpose_item(kp->b_w_uv, 128, 512, WUKV, 512, scr, r, lane); }
                rope_table((float2*)(ws + WS_ROPE), w0 >> 3, nw0 >> 3, tid);
                const int gt = w0 * 64 + lane, NT = nw0 * 64; v4u z = {0u, 0u, 0u, 0u};
                for (int i = gt; i < (N0 - N0_REAL) * DM / 8; i += NT) *((v4u*)(WIN0 + (size_t)N0_REAL * DM) + i) = z;
            }
        } else {
        for (int it = vcu; it < 96; it += G) {
            LAS float* red = (LAS float*)(lds + 131072);
            const int kb = wave * 128;
            for (int i = lane; i < 512; i += 64) { const float cv = kp->c[(i >> 7) * DM + kb + (i & 127)]; scr[i] = cv / (1.f + __expf(-cv)); }
            LDS_WAIT(); asm volatile("" ::: "memory");
            const int l = it / 48, jc = (it % 48) * 64 + lane; const float* w = kp->ada_w + (size_t)l * DM * 3072 + (size_t)kb * 3072 + jc;
            float a0 = 0.f, a1 = 0.f, a2 = 0.f, a3 = 0.f;
#pragma unroll 16
            for (int i = 0; i < 128; ++i) { const float wv = w[(size_t)i * 3072]; a0 += scr[i] * wv; a1 += scr[128 + i] * wv; a2 += scr[256 + i] * wv; a3 += scr[384 + i] * wv; }
            red[(wave * 4 + 0) * 64 + lane] = a0; red[(wave * 4 + 1) * 64 + lane] = a1; red[(wave * 4 + 2) * 64 + lane] = a2; red[(wave * 4 + 3) * 64 + lane] = a3;
            __syncthreads();
            if (wave < 4) { float sum = kp->ada_b[l * 3072 + jc];
#pragma unroll
                for (int w8 = 0; w8 < 8; ++w8) sum += red[(w8 * 4 + wave) * 64 + lane];
                ((float*)(ws + WS_MOD))[(size_t)l * 4 * 3072 + (size_t)wave * 3072 + jc] = sum; }
            __syncthreads();
        }
        { const bool split = G > 96; const int w0 = split ? (vcu - 96) * 8 + wave : gw, nw0 = split ? (G - 96) * 8 : NGW;
          if (!split || vcu >= 96) {
              constexpr int I0 = 16 * (N0_REAL / 32), I4 = 4 * 24, I5 = 2 * 16, I6 = 2 * 16;
              for (int it = w0; it < I0 + (rebal ? I4 + I5 + I6 : 0); it += nw0) { int r = it;
                  if (r < I0) { transpose_item(kp->even_w_in, DM, N0_REAL, WIN0, 0, scr, r, lane); continue; } r -= I0;
                  if (r < I4) { transpose_item(kp->b_w_uq, 256, 768, WUQ, 0, scr, r, lane); continue; } r -= I4;
                  if (r < I5) { transpose_item(kp->b_w_uk, 128, 512, WUKV, 0, scr, r, lane); continue; } r -= I5;
                  transpose_item(kp->b_w_uv, 128, 512, WUKV, 512, scr, r, lane); }
              if (rebal) rope_table((float2*)(ws + WS_ROPE), w0 >> 3, nw0 >> 3, tid);
              const int gt = w0 * 64 + lane, NT = nw0 * 64; v4u z = {0u, 0u, 0u, 0u};
              for (int i = gt; i < (N0 - N0_REAL) * DM / 8; i += NT) *((v4u*)(WIN0 + (size_t)N0_REAL * DM) + i) = z;
          } }
        }
    }
    SEAM(0);
    if (IN(1)) { KP_LOAD();
        if (rebal) { LAS float* scr = (LAS float*)(lds + wave * 16384);
            for (int it = gw; it < 16 * (N0_REAL / 32); it += NGW) transpose_item(kp->even_w_in, DM, N0_REAL, WIN0, 0, scr, it, lane); }
        adaln_rows(kp->x, kp->norm_w, MOD, H, gw, NGW, lane); }
    SEAM(1);
    if (IN(2)) { KP_LOAD();
        if (rebal) {
            pg8::Gemm g{H, WIN0, TOK, 2048, DM, DM}; pg8::StaticOrder S; S.init(TOK, 2048, G, bx);
            pg8::EpiStore E{P, N0, 0, 1.f};
            pg8::gemm_phase<pg8::EpiStore, pg8::StaticOrder, PG8_ALIGN, PG8_SP2>(lds, g, S, E);
        } else {
        pg8::Gemm g{H, WIN0, TOK, N0, DM, DM}; pg8::StaticOrder S; S.init(TOK, N0, G, bx);
        pg8::EpiStore E{P, N0, 0, 1.f};
        pg8::gemm_phase<pg8::EpiStore, pg8::StaticOrder, PG8_ALIGN, PG8_SP2>(lds, g, S, E);
        { constexpr int NU = (TOK / 256) * (N0 / 256); const int rem = NU % G; const bool idle = rem == 0 || bx >= rem; const int widx = rem == 0 ? bx : bx - rem, NW = rem == 0 ? G : G - rem;
          if (idle) { LAS float* scr = (LAS float*)(lds + wave * 16384);
              constexpr int I1 = 16 * 32, I2 = 16 * (N1 / 32), I4 = 4 * 24, I5 = 2 * 16, I6 = 2 * 16;
              for (int it = widx * 8 + wave; it < I1 + I2 + I4 + I5 + I6; it += NW * 8) { int r = it;
                  if (r < I4) { transpose_item(kp->b_w_uq, 256, 768, WUQ, 0, scr, r, lane); continue; } r -= I4;
                  if (r < I5) { transpose_item(kp->b_w_uk, 128, 512, WUKV, 0, scr, r, lane); continue; } r -= I5;
                  if (r < I6) { transpose_item(kp->b_w_uv, 128, 512, WUKV, 512, scr, r, lane); continue; } r -= I6;
                  if (r < I1) { transpose_item(kp->even_w_out, DM, DM, WOUT0, 0, scr, r, lane); continue; } r -= I1;
                  transpose_item(kp->odd_w_in, DM, N1, WIN1, 0, scr, r, lane); }
              rope_table((float2*)(ws + WS_ROPE), widx, NW, tid); } }
        }
    }
    SEAM(2);
    if (IN(3)) { KP_LOAD(); post_rows(kp->a_q_norm, kp->a_k_norm, kp->b_q_lora_norm, kp->b_kv_lora_norm, P, CQN, CKVN, ROPE, gw, NGW, lane); }
    SEAM(3);
    if (IN(4)) { KP_LOAD();
        if (rebal) {
            if (bx < 192) {
                { int kk = 256; asm volatile("" : "+s"(kk)); pg8::Gemm g{CQN, WUQ, TOK, 768, kk, kk}; pg8::StaticOrder S; S.init(TOK, 768, 192, bx);
                  pg8::EpiStore E{QB, 768, 768, C2B};
                  pg8::gemm_phase<pg8::EpiStore, pg8::StaticOrder, PG8_ALIGN, PG8_SP2>(lds, g, S, E); }
                { int kk = 128; asm volatile("" : "+s"(kk)); pg8::Gemm g{CKVN, WUKV, TOK, 1024, kk, kk}; pg8::StaticOrder S; S.init(TOK, 1024, 192, bx);
                  pg8::EpiStore E{KVB, 1024, 0, 1.f};
                  pg8::gemm_phase<pg8::EpiStore, pg8::StaticOrder, PG8_ALIGN, PG8_SP2>(lds, g, S, E); }
            } else {
                pg8::Gemm g{H, WIN0 + (size_t)2048 * DM, TOK, 256, DM, DM}; pg8::StaticOrder S; S.init(TOK, 256, 64, bx - 192);
                pg8::EpiStore E{P + 2048, N0, 0, 1.f};
                pg8::gemm_phase<pg8::EpiStore, pg8::StaticOrder, PG8_ALIGN, PG8_SP2>(lds, g, S, E);
            }
            { LAS float* scr = (LAS float*)(lds + wave * 16384); constexpr int I1 = 16 * 32, I2 = 16 * (N1 / 32);
              for (int it = gw; it < I1 + I2; it += NGW) { if (it < I1) transpose_item(kp->even_w_out, DM, DM, WOUT0, 0, scr, it, lane); else transpose_item(kp->odd_w_in, DM, N1, WIN1, 0, scr, it - I1, lane); } }
        } else {
        { int kk = 256; asm volatile("" : "+s"(kk)); pg8::Gemm g{CQN, WUQ, TOK, 768, kk, kk}; pg8::StaticOrder S; S.init(TOK, 768, G, bx);
          pg8::EpiStore E{QB, 768, 768, C2B};
          pg8::gemm_phase<pg8::EpiStore, pg8::StaticOrder, PG8_ALIGN, PG8_SP2>(lds, g, S, E); }
        { int kk = 128; asm volatile("" : "+s"(kk)); pg8::Gemm g{CKVN, WUKV, TOK, 1024, kk, kk}; pg8::StaticOrder S; S.init(TOK, 1024, G, bx);
          pg8::EpiStore E{KVB, 1024, 0, 1.f};
          pg8::gemm_phase<pg8::EpiStore, pg8::StaticOrder, PG8_ALIGN, PG8_SP2>(lds, g, S, E); }
        }
    }
    SEAM(4);
    if (IN(5)) { KP_LOAD();
        for (int L = vcu; L < 512; L += G) {
            if (L < 256) {
                const int bh = L >> 3, b = bh >> 3, h = bh & 7, qb = L & 7; const size_t r0 = (size_t)b * SEQ;
                att2::attn_unit<96, 0>(lds, QB + r0 * 768 + h * 96, KVB + r0 * 1024 + h * 64, P + r0 * N0 + C_KR, KVB + r0 * 1024 + 512 + h * 64, P + r0 * N0 + C_GB + h * 64, MIX + r0 * DM + 512 + h * 64,
                                       768, 1024, N0, 1024, N0, DM, qb * 512, 0, SEQ / 64, 0.f, 0.f, ROPE);
            } else {
                const int Lr = L - 256, grp = Lr >> 5, b = grp >> 1, kvh = grp & 1, h = kvh * 4 + ((Lr & 31) >> 3), qb = Lr & 7; const size_t r0 = (size_t)b * SEQ;
                const bf16* Pb = P + r0 * N0;
                att2::attn_unit<64, 0>(lds, Pb + C_QA + h * 64, Pb + C_KA + kvh * 64, Pb + C_KA + kvh * 64, Pb + C_VA + kvh * 64, Pb + C_GA + h * 64, MIX + r0 * DM + h * 64,
                                       N0, N0, N0, N0, N0, DM, qb * 512, 0, SEQ / 64, 0.f, 0.f, ROPE, kp->a_q_norm);
            }
        }
    }
    SEAM(5);
    if (IN(6)) { KP_LOAD();
        pg8::Gemm g{MIX, WOUT0, TOK, DM, DM, DM}; pg8::StaticOrder S; S.init(TOK, DM, G, bx);
        if (fuse_norm) {
            pg8::PanelRms st{(float*)(ws + WS_XB6), (unsigned*)(ws + WS_CNT6), EPS};
            pg8::EpiResNorm<false> E{kp->x, kp->out, MOD + 2048, DM, st, kp->norm_w + DM, MOD + 4 * 3072, H, KVB};
            pg8::gemm_phase<pg8::EpiResNorm<false>, pg8::StaticOrder, false, PG8_SP2>(lds, g, S, E);
        } else {
            pg8::EpiRes E{kp->x, kp->out, MOD + 2048, DM};
            pg8::gemm_phase<pg8::EpiRes, pg8::StaticOrder, PG8_ALIGN, PG8_SP2>(lds, g, S, E);
        }
    }
    SEAM(6);
    if (IN(7) && !fuse_norm) { KP_LOAD(); adaln_rows(kp->out, kp->norm_w + DM, MOD + 4 * 3072, H, gw, NGW, lane); }
    if (!fuse_norm) SEAM(7);
    if (IN(8)) { KP_LOAD();
        pg8::Gemm g{H, WIN1, TOK, N1, DM, DM}; pg8::StaticOrder S; S.init(TOK, N1, G, bx);
        pg8::EpiStore E{P, N1, 1024, C2A};
        pg8::gemm_phase<pg8::EpiStore, pg8::StaticOrder, PG8_ALIGN, PG8_SP2>(lds, g, S, E);
        { constexpr int NU = (TOK / 256) * (N1 / 256); const int rem = NU % G; const bool idle = rem == 0 || bx >= rem; const int widx = rem == 0 ? bx : bx - rem, NW = rem == 0 ? G : G - rem;
          if (idle) { LAS float* scr = (LAS float*)(lds + wave * 16384);
              for (int it = widx * 8 + wave; it < 16 * 32; it += NW * 8) transpose_item(kp->odd_w_out, DM, DM, WOUT1, 0, scr, it, lane); } }
    }
    SEAM(8);
    if (IN(9)) { KP_LOAD();
        for (int L = vcu; L < 512; L += G) {
            const int grp = L >> 5, b = grp >> 2, kvh = grp & 3, h = kvh * 4 + 2 * ((L & 31) >> 4), u = L & 15; const size_t r0 = (size_t)b * SEQ;
            const bf16* Pb = P + r0 * N1;
            att6::attn_unit_win(lds, Pb + C_QC + h * 64, Pb + C_KC + kvh * 64, Pb + C_VC + kvh * 64, Pb + C_GC + h * 64, MIX + r0 * DM + h * 64,
                                N1, DM, u * 256, u * 4 - 2, SEQ / 64, exp2f(-0.5f * (float)(h + 1)) * LOG2E, kp->c_sink[h] * LOG2E, exp2f(-0.5f * (float)(h + 2)) * LOG2E, kp->c_sink[h + 1] * LOG2E);
        }
    }
    SEAM(9);
    if (IN(10)) { KP_LOAD();
        pg8::Gemm g{MIX, WOUT1, TOK, DM, DM, DM}; pg8::StaticOrder S; S.init(TOK, DM, G, bx);
        if (fuse_norm) {
            pg8::PanelRms st{(float*)(ws + WS_XB10), (unsigned*)(ws + WS_CNT10), EPS};
            pg8::EpiResNorm<true> E{kp->out, kp->out, MOD + 4 * 3072 + 2048, DM, st, kp->final_norm, nullptr, nullptr, KVB};
            pg8::gemm_phase<pg8::EpiResNorm<true>, pg8::StaticOrder, false, PG8_SP2>(lds, g, S, E);
        } else {
            pg8::EpiRes E{kp->out, kp->out, MOD + 4 * 3072 + 2048, DM};
            pg8::gemm_phase<pg8::EpiRes, pg8::StaticOrder, PG8_ALIGN, PG8_SP2>(lds, g, S, E);
        }
    }
    if (!fuse_norm) SEAM(10);
    if (IN(11) && !fuse_norm) { KP_LOAD();
        float* outp = kp->out; const float* fnw = kp->final_norm; constexpr int NR = 4;
        for (int mb = gw; mb < TOK; mb += NR * NGW) {
            f32x4 v[NR][4]; float ss[NR]; int mr[NR];
#pragma unroll
            for (int r = 0; r < NR; ++r) { const int m = mb + r * NGW; mr[r] = m < TOK ? m : mb; const f32x4* xr = (const f32x4*)(outp + (size_t)mr[r] * DM) + lane;
#pragma unroll
                for (int j = 0; j < 4; ++j) v[r][j] = xr[64 * j]; }
#pragma unroll
            for (int r = 0; r < NR; ++r) { float s_ = 0.f;
#pragma unroll
                for (int j = 0; j < 4; ++j) s_ += (v[r][j].x * v[r][j].x + v[r][j].y * v[r][j].y) + (v[r][j].z * v[r][j].z + v[r][j].w * v[r][j].w);
                ss[r] = 1.f / sqrtf(wave_sum(s_) * (1.f / DM) + EPS); }
#pragma unroll
            for (int j = 0; j < 4; ++j) { const f32x4 w = *(const f32x4*)(fnw + 4 * (lane + 64 * j));
#pragma unroll
                for (int r = 0; r < NR; ++r) { if (r > 0 && mb + r * NGW >= TOK) continue; ((f32x4*)(outp + (size_t)mr[r] * DM) + lane)[64 * j] = v[r][j] * ss[r] * w; } }
        }
    }
#undef IN
#undef SEAM
#undef MOD
#undef ROPE
#undef WIN0
#undef WOUT0
#undef WIN1
#undef WOUT1
#undef WUQ
#undef WUKV
#undef H
#undef P
#undef QB
#undef KVB
#undef MIX
#undef CQN
#undef CKVN
}

#ifndef MK_MULTI
#define MK_MULTI 0
#endif
extern "C" void kernel_launch(void* const* d_in, const int* in_sizes, int n_in, void* d_out, int out_size, void* d_ws, size_t ws_size, hipStream_t stream) {
    static int grid = 0;
    if (grid == 0) {
        if (n_in != 18 || out_size != TOK * DM || ws_size < WS_END) { fprintf(stderr, "kernel_launch: unexpected problem (n_in %d out %d ws %zu)\n", n_in, out_size, ws_size); grid = -1; return; }
        int dev = 0, cus = 0, per_cu = 0;
        hipGetDevice(&dev); hipDeviceGetAttribute(&cus, hipDeviceAttributeMultiprocessorCount, dev);
        if (hipFuncSetAttribute((const void*)mega_fwd, hipFuncAttributeMaxDynamicSharedMemorySize, LDS_BYTES) != hipSuccess) { fprintf(stderr, "kernel_launch: hipFuncSetAttribute failed\n"); grid = -1; return; }
        if (hipOccupancyMaxActiveBlocksPerMultiprocessor(&per_cu, (const void*)mega_fwd, 512, LDS_BYTES) != hipSuccess || per_cu < 1) { fprintf(stderr, "kernel_launch: occupancy query says %d\n", per_cu); per_cu = 1; }
        (void)hipGetLastError();
        grid = cus * (per_cu > 1 ? 1 : per_cu);
    }
    if (grid < 0) return;
    if (hipMemsetAsync((char*)d_ws + WS_CTL, 0, WS_MOD + 2 * 4 * 3072 * sizeof(float), stream) != hipSuccess) {   fprintf(stderr, "kernel_launch: memset failed\n"); return; }
    Params p{};
    const float** pf = (const float**)&p;
    for (int i = 0; i < 18; ++i) pf[i] = (const float*)d_in[i];
    p.out = (float*)d_out; p.ws = (unsigned char*)d_ws;
#if MK_MULTI
    for (int k = 0; k < NPHASE; ++k) hipLaunchKernelGGL(mega_fwd, dim3(grid), dim3(512), LDS_BYTES, stream, p, k, k + 1);
#else
    int lo = 0, hi = NPHASE;
    void* args[] = {&p, &lo, &hi};
    hipError_t e = hipLaunchCooperativeKernel((void*)mega_fwd, dim3(grid), dim3(512), args, LDS_BYTES, stream);
    if (e != hipSuccess) fprintf(stderr, "cooperative launch failed: %s (grid %d)\n", hipGetErrorString(e), grid);
#endif
}
```

```cpp
#include <hip/hip_runtime.h>
#include <hip/hip_cooperative_groups.h>
#include <cstdio>
#include <cstdint>
#include <cmath>
namespace cg = cooperative_groups;
namespace pg8 {
#define PG8_LAS __attribute__((address_space(3)))
typedef unsigned short bf16_t;
typedef short bf16x8 __attribute__((ext_vector_type(8)));
typedef float f32x4 __attribute__((ext_vector_type(4)));
typedef unsigned u32x4 __attribute__((ext_vector_type(4)));
constexpr int BM = 256, BK = 64, HALF = 128, HTB = HALF * BK * 2  , STAGE_BYTES = 8 * HTB, NXCD = 8, WGM = 8;

__host__ __device__ __forceinline__ int lds_byte(int r, int c) { const int st = (r >> 4) * 2 + (c >> 5), rr = r & 15, cc = c & 31, ob = rr * 64 + cc * 2; return st * 1024 + (ob ^ (((ob >> 9) & 1) << 5)); }
__host__ __device__ __forceinline__ void stage_rc(int b, int& R, int& C) { const int st = b / 1024, sb = b % 1024, swz = sb ^ (((sb >> 9) & 1) << 5); R = (st >> 1) * 16 + swz / 64; C = (st & 1) * 32 + (swz % 64) / 2; }
__host__ __device__ __forceinline__ int perm32(int rho) { const int n = rho >> 4, i = rho & 15; return 8 * (i >> 2) + 4 * n + (i & 3); }

struct Unit { int pm, pn; };
struct Gemm { const bf16_t* A; const bf16_t* Bt; int M, N, K, lda; };

struct StaticOrder {
    int nM, nN, nwg, G, c;
    __host__ __device__ void init(int M, int N, int G_, int c_) { nM = M / BM; nN = N / BM; nwg = nM * nN; G = G_; c = c_; }
    __host__ __device__ bool next(int i, Unit& u) const {
        const long L = (long)i * G + c; if (L >= nwg) return false;
        int wgid = (int)L; { const int q = nwg / NXCD, r = nwg % NXCD, xcd = wgid % NXCD, off = wgid / NXCD; wgid = (xcd < r ? xcd * (q + 1) : r * (q + 1) + (xcd - r) * q) + off; }
        const int nig = WGM * nN, gid = wgid / nig, fm = gid * WGM, gsz = (nM - fm) < WGM ? (nM - fm) : WGM;
        u.pm = fm + ((wgid % nig) % gsz); u.pn = (wgid % nig) / gsz; return true;
    }
    __device__ __forceinline__ void a_ready(const Unit&) const {}
    __device__ __forceinline__ void done(const Unit&) const {}
};

__device__ __forceinline__ unsigned cvt_pk_bf16(float lo, float hi) { unsigned r; asm volatile("v_cvt_pk_bf16_f32 %0, %1, %2" : "=v"(r) : "v"(lo), "v"(hi)); return r; }
typedef float f32x2 __attribute__((ext_vector_type(2)));
template <class Epi, class Sched, bool ALIGN_EPI = false, bool SP2 = false>
__device__ __forceinline__ void gemm_phase(PG8_LAS unsigned char* lds, const Gemm g, const Sched& S, const Epi& E) {
    const int tid = threadIdx.x, wid = __builtin_amdgcn_readfirstlane(tid >> 6), lane = tid & 63, wr = wid >> 2, wc = wid & 3, fr = lane & 15, fq = lane >> 4;
    const int K = g.K, nt = K / BK;
    unsigned voffA[2], voffB[2];
#pragma unroll
    for (int i = 0; i < 2; ++i) { int R, C; stage_rc(tid * 16 + i * 8192, R, C); const int Rb = Epi::PERM ? ((R & ~31) + perm32(R & 31)) : R;
        voffA[i] = (unsigned)(R * g.lda + C) * 2u; voffB[i] = (unsigned)(Rb * K + C) * 2u; }
    const size_t kstep = (size_t)(BK * 2);
    const size_t hstepA = (size_t)HALF * g.lda * 2, hstepB = (size_t)HALF * K * 2;
    const size_t tstepA = 2 * hstepA, tstepB = 2 * hstepB;
    const unsigned ldsw = (unsigned)wid * 1024u;
    const int aoff = lds_byte(wr * 64 + fr, fq * 8), boff = lds_byte(wc * 32 + fr, fq * 8);
#define PG8_SA(b, h) (((b) * 2 + (h)) * HTB)
#define PG8_SB(b, h) ((4 + (b) * 2 + (h)) * HTB)
#define PG8_STAGE(bufoff, gbase, voff) do { _Pragma("unroll") for (int _i = 0; _i < 2; ++_i) \
        __builtin_amdgcn_global_load_lds((const unsigned*)((const char*)(gbase) + (voff)[_i]), (PG8_LAS unsigned*)(lds + (bufoff) + ldsw + _i * 8192), 16, 0, 0); } while (0)
#define PG8_LDA(dst, b, h) do { _Pragma("unroll") for (int m = 0; m < 4; ++m) _Pragma("unroll") for (int k = 0; k < 2; ++k) dst[m][k] = *(const PG8_LAS bf16x8*)(lds + PG8_SA(b, h) + aoff + m * 2048 + k * 1024); } while (0)
#define PG8_LDB(dst, b, h) do { _Pragma("unroll") for (int n = 0; n < 2; ++n) _Pragma("unroll") for (int k = 0; k < 2; ++k) dst[n][k] = *(const PG8_LAS bf16x8*)(lds + PG8_SB(b, h) + boff + n * 2048 + k * 1024); } while (0)
#define PG8_MMA(ai, bj, At, Bt) do { __builtin_amdgcn_s_setprio(1); _Pragma("unroll") for (int m = 0; m < 4; ++m) _Pragma("unroll") for (int n = 0; n < 2; ++n) _Pragma("unroll") for (int k = 0; k < 2; ++k) \
        acc[ai][bj][m][n] = __builtin_amdgcn_mfma_f32_16x16x32_bf16(Bt[n][k], At[m][k], acc[ai][bj][m][n], 0, 0, 0); __builtin_amdgcn_s_setprio(0); } while (0)
#define PG8_WAIT_V(n) asm volatile("s_waitcnt vmcnt(" #n ")" ::: "memory")
#define PG8_WAIT_L(n) asm volatile("s_waitcnt lgkmcnt(" #n ")" ::: "memory")
#define PG8_BAR __builtin_amdgcn_s_barrier()
#define PG8_SCHED __builtin_amdgcn_sched_barrier(0)
    Unit cur, nxt; int ui = 0;
    if (!S.next(0, cur)) return;
    f32x4 acc[2][2][4][2];
#pragma unroll
    for (int a = 0; a < 2; ++a)
#pragma unroll
        for (int b = 0; b < 2; ++b)
#pragma unroll
            for (int m = 0; m < 4; ++m)
#pragma unroll
                for (int n = 0; n < 2; ++n) acc[a][b][m][n] = (f32x4){0.f, 0.f, 0.f, 0.f};
    bf16x8 At[4][2], B0[2][2], B1[2][2];
    const char* cA = (const char*)g.A + (size_t)cur.pm * tstepA; const char* cB = (const char*)g.Bt + (size_t)cur.pn * tstepB;
    S.a_ready(cur);
    if constexpr (SP2) {
        PG8_STAGE(PG8_SB(0, 0), cB, voffB); PG8_STAGE(PG8_SB(0, 1), cB + hstepB, voffB); PG8_STAGE(PG8_SA(0, 0), cA, voffA); PG8_STAGE(PG8_SA(0, 1), cA + hstepA, voffA);
        if (wr == 1) PG8_BAR;
        PG8_WAIT_V(2); PG8_BAR;
        PG8_STAGE(PG8_SB(1, 0), cB + kstep, voffB); PG8_STAGE(PG8_SA(1, 0), cA + kstep, voffA); PG8_STAGE(PG8_SB(1, 1), cB + hstepB + kstep, voffB);
        PG8_WAIT_V(6); PG8_BAR;
    } else {
        PG8_STAGE(PG8_SB(0, 0), cB, voffB); PG8_STAGE(PG8_SA(0, 0), cA, voffA); PG8_STAGE(PG8_SB(0, 1), cB + hstepB, voffB); PG8_STAGE(PG8_SA(0, 1), cA + hstepA, voffA);
        if (wr == 1) PG8_BAR;
        PG8_WAIT_V(4); PG8_BAR;
        PG8_STAGE(PG8_SB(1, 0), cB + kstep, voffB); PG8_STAGE(PG8_SA(1, 0), cA + kstep, voffA); PG8_STAGE(PG8_SB(1, 1), cB + hstepB + kstep, voffB);
        PG8_WAIT_V(6); PG8_BAR;
    }
    for (;;) {
        const bool has_next = S.next(ui + 1, nxt);
        const char* nA = has_next ? (const char*)g.A + (size_t)nxt.pm * tstepA : cA; const char* nB = has_next ? (const char*)g.Bt + (size_t)nxt.pn * tstepB : cB;
        for (int t = 0; t < nt; t += 2) {
            const bool last = (t == nt - 2);
            const char* a1 = cA + (size_t)(t + 1) * kstep;
            const char* a2 = last ? nA : cA + (size_t)(t + 2) * kstep; const char* b2 = last ? nB : cB + (size_t)(t + 2) * kstep;
            const char* a3 = a2 + kstep; const char* b3 = b2 + kstep;
            if (last && has_next) S.a_ready(nxt);
            if constexpr (SP2) {
            PG8_LDB(B0, 0, 0); PG8_LDB(B1, 0, 1); PG8_SCHED; PG8_LDA(At, 0, 0); PG8_STAGE(PG8_SA(1, 1), a1 + hstepA, voffA);
            PG8_WAIT_V(8); PG8_WAIT_L(0); PG8_BAR; PG8_MMA(0, 0, At, B0); PG8_MMA(0, 1, At, B1); PG8_BAR; PG8_SCHED;
            PG8_LDA(At, 0, 1); PG8_STAGE(PG8_SB(0, 0), b2, voffB); PG8_STAGE(PG8_SB(0, 1), b2 + hstepB, voffB); PG8_STAGE(PG8_SA(0, 0), a2, voffA);
            PG8_WAIT_V(8); PG8_WAIT_L(0); PG8_BAR; PG8_MMA(1, 0, At, B0); PG8_MMA(1, 1, At, B1); PG8_BAR; PG8_SCHED;
            PG8_LDB(B0, 1, 0); PG8_LDB(B1, 1, 1); PG8_SCHED; PG8_LDA(At, 1, 0); PG8_STAGE(PG8_SA(0, 1), a2 + hstepA, voffA);
            PG8_WAIT_V(8); PG8_WAIT_L(0); PG8_BAR; PG8_MMA(0, 0, At, B0); PG8_MMA(0, 1, At, B1); PG8_BAR; PG8_SCHED;
            PG8_LDA(At, 1, 1); PG8_STAGE(PG8_SB(1, 0), b3, voffB); PG8_STAGE(PG8_SB(1, 1), b3 + hstepB, voffB); PG8_STAGE(PG8_SA(1, 0), a3, voffA);
            PG8_WAIT_V(8); PG8_WAIT_L(0); PG8_BAR; PG8_MMA(1, 0, At, B0); PG8_MMA(1, 1, At, B1); PG8_BAR; PG8_SCHED;
            } else {
            PG8_LDB(B0, 0, 0); PG8_SCHED; PG8_LDA(At, 0, 0); PG8_STAGE(PG8_SA(1, 1), a1 + hstepA, voffA);
            PG8_WAIT_L(8); PG8_BAR; PG8_WAIT_L(0); PG8_MMA(0, 0, At, B0); PG8_BAR; PG8_SCHED;
            PG8_LDB(B1, 0, 1); PG8_STAGE(PG8_SB(0, 0), b2, voffB);
            PG8_BAR; PG8_WAIT_L(0); PG8_MMA(0, 1, At, B1); PG8_BAR;
            PG8_LDA(At, 0, 1); PG8_STAGE(PG8_SA(0, 0), a2, voffA);
            PG8_BAR; PG8_WAIT_L(0); PG8_MMA(1, 0, At, B0); PG8_BAR; PG8_SCHED;
            PG8_STAGE(PG8_SB(0, 1), b2 + hstepB, voffB);
            PG8_WAIT_V(6); PG8_BAR; PG8_MMA(1, 1, At, B1); PG8_BAR;
            PG8_LDB(B0, 1, 0); PG8_SCHED; PG8_LDA(At, 1, 0); PG8_STAGE(PG8_SA(0, 1), a2 + hstepA, voffA);
            PG8_WAIT_L(8); PG8_BAR; PG8_WAIT_L(0); PG8_MMA(0, 0, At, B0); PG8_BAR; PG8_SCHED;
            PG8_LDB(B1, 1, 1); PG8_STAGE(PG8_SB(1, 0), b3, voffB);
            PG8_BAR; PG8_WAIT_L(0); PG8_MMA(0, 1, At, B1); PG8_BAR;
            PG8_LDA(At, 1, 1); PG8_STAGE(PG8_SA(1, 0), a3, voffA);
            PG8_BAR; PG8_WAIT_L(0); PG8_MMA(1, 0, At, B0); PG8_BAR; PG8_SCHED;
            PG8_STAGE(PG8_SB(1, 1), b3 + hstepB, voffB);
            PG8_WAIT_V(6); PG8_BAR; PG8_MMA(1, 1, At, B1); PG8_BAR;
            }
        }
        if constexpr (ALIGN_EPI) { if (wr == 0) PG8_BAR; }
        if constexpr (!Epi::AFTER_DRAIN) { E(acc, cur, wr, wc, fr, fq); S.done(cur); }
        if (!has_next) break;
#pragma unroll
        for (int a = 0; a < 2; ++a)
#pragma unroll
            for (int b = 0; b < 2; ++b)
#pragma unroll
                for (int m = 0; m < 4; ++m)
#pragma unroll
                    for (int n = 0; n < 2; ++n) acc[a][b][m][n] = (f32x4){0.f, 0.f, 0.f, 0.f};
        cur = nxt; cA = nA; cB = nB; ++ui;
        if constexpr (ALIGN_EPI) { if (wr == 1) PG8_BAR; }
    }
    PG8_WAIT_V(0);
    if constexpr (!ALIGN_EPI) { if (wr == 0) PG8_BAR; }
    PG8_BAR;
    if constexpr (Epi::AFTER_DRAIN) { E.fused(acc, cur, wr, wc, fr, fq, lds, wid, lane); S.done(cur); }
#undef PG8_SA
#undef PG8_SB
#undef PG8_STAGE
#undef PG8_LDA
#undef PG8_LDB
#undef PG8_MMA
#undef PG8_WAIT_V
#undef PG8_WAIT_L
#undef PG8_BAR
#undef PG8_SCHED
}
}
#define PG8_SP2 true
#define PG8_ALIGN true
namespace pg8 {
typedef unsigned u32x2 __attribute__((ext_vector_type(2)));
struct EpiStore {
    static constexpr bool PERM = true, AFTER_DRAIN = false;
    bf16_t* O; int ldc; int scale_cols; float scale0;
    __device__ __forceinline__ void operator()(const f32x4 (&acc)[2][2][4][2], const Unit& u, int wr, int wc, int fr, int fq) const {
        const int row0 = u.pm * BM + wr * 64 + fr; const int col0 = u.pn * BM + wc * 32 + 8 * fq;
        const float sc = (u.pn * BM < scale_cols) ? scale0 : 1.f;
#pragma unroll
        for (int ai = 0; ai < 2; ++ai)
#pragma unroll
            for (int m = 0; m < 4; ++m) { bf16_t* rowp = O + (size_t)(row0 + ai * HALF + m * 16) * ldc + col0;
#pragma unroll
                for (int bj = 0; bj < 2; ++bj) { f32x4 v0 = acc[ai][bj][m][0] * sc, v1 = acc[ai][bj][m][1] * sc;
                    u32x4 w; w.x = cvt_pk_bf16(v0[0], v0[1]); w.y = cvt_pk_bf16(v0[2], v0[3]); w.z = cvt_pk_bf16(v1[0], v1[1]); w.w = cvt_pk_bf16(v1[2], v1[3]);
                    *(u32x4*)(rowp + bj * HALF) = w; } }
    }
};
struct EpiQb {
    static constexpr bool PERM = false, AFTER_DRAIN = false;
    bf16_t* O; int ldc; const float2* rope; float sc;
    __device__ __forceinline__ void operator()(const f32x4 (&acc)[2][2][4][2], const Unit& u, int wr, int wc, int fr, int fq) const {
        const int row0 = u.pm * BM + wr * 64 + fr;
#pragma unroll
        for (int bj = 0; bj < 2; ++bj) { const int colg = u.pn * BM + bj * HALF + wc * 32; const bool is_rope = ((colg >> 5) % 3) == 2;
#pragma unroll
            for (int ai = 0; ai < 2; ++ai)
#pragma unroll
                for (int m = 0; m < 4; ++m) { const int row = row0 + ai * HALF + m * 16; f32x4 v0 = acc[ai][bj][m][0], v1 = acc[ai][bj][m][1];
                    if (is_rope) { const float2* rp = rope + (size_t)(row & 4095) * 16 + 4 * fq;
#pragma unroll
                        for (int e = 0; e < 4; ++e) { const float2 cs = rp[e]; const float x1 = v0[e], x2 = v1[e]; v0[e] = x1 * cs.x - x2 * cs.y; v1[e] = x1 * cs.y + x2 * cs.x; } }
                    v0 = v0 * sc; v1 = v1 * sc; bf16_t* rowp = O + (size_t)row * ldc + colg + 4 * fq;
                    u32x2 a, b; a.x = cvt_pk_bf16(v0[0], v0[1]); a.y = cvt_pk_bf16(v0[2], v0[3]); b.x = cvt_pk_bf16(v1[0], v1[1]); b.y = cvt_pk_bf16(v1[2], v1[3]);
                    *(u32x2*)rowp = a; *(u32x2*)(rowp + 16) = b; asm volatile("" ::: "memory"); } }
    }
};
struct EpiRes {
    static constexpr bool PERM = true, AFTER_DRAIN = false;
    const float* base; float* out; const float* gate; int ldc;
    __device__ __forceinline__ void operator()(const f32x4 (&acc)[2][2][4][2], const Unit& u, int wr, int wc, int fr, int fq) const {
        const int row0 = u.pm * BM + wr * 64 + fr; const int b = (u.pm * BM) >> 12; const int col0 = u.pn * BM + wc * 32 + 8 * fq;
#pragma unroll
        for (int bj = 0; bj < 2; ++bj) { const int col = col0 + bj * HALF; const f32x4 g0 = *(const f32x4*)(gate + (size_t)b * 3072 + col), g1 = *(const f32x4*)(gate + (size_t)b * 3072 + col + 4);
#pragma unroll
            for (int ai = 0; ai < 2; ++ai)
#pragma unroll
                for (int m = 0; m < 4; ++m) { const size_t off = (size_t)(row0 + ai * HALF + m * 16) * ldc + col;
                    const f32x4 b0 = *(const f32x4*)(base + off), b1 = *(const f32x4*)(base + off + 4);
                    *(f32x4*)(out + off) = b0 + g0 * acc[ai][bj][m][0]; *(f32x4*)(out + off + 4) = b1 + g1 * acc[ai][bj][m][1]; } }
    }
};
struct PanelRms {
    float* xbuf; unsigned* cnt; float eps;
    __device__ __forceinline__ void run(const f32x4 (&v)[2][2][4][2], const Unit& u, int wr, int wc, int fr, int fq, PG8_LAS unsigned char* lds, int wid, int lane) const {
        PG8_LAS float* Pp = (PG8_LAS float*)lds;
        PG8_LAS float* S = (PG8_LAS float*)(lds + 4096);
#pragma unroll
        for (int ai = 0; ai < 2; ++ai)
#pragma unroll
            for (int m = 0; m < 4; ++m) { float q = 0.f;
#pragma unroll
                for (int bj = 0; bj < 2; ++bj)
#pragma unroll
                    for (int n = 0; n < 2; ++n) { const f32x4 x = v[ai][bj][m][n]; q += (x[0] * x[0] + x[1] * x[1]) + (x[2] * x[2] + x[3] * x[3]); }
                q += __shfl_xor(q, 16); q += __shfl_xor(q, 32);
                if (fq == 0) Pp[(ai * HALF + wr * 64 + m * 16 + fr) * 4 + wc] = q; }
        asm volatile("s_waitcnt lgkmcnt(0)" ::: "memory"); __builtin_amdgcn_s_barrier(); asm volatile("" ::: "memory");
        const int row = wid * 32 + (lane & 31);
        if (lane < 32) { const f32x4 a = *(const PG8_LAS f32x4*)(Pp + row * 4);
            __hip_atomic_store(xbuf + ((size_t)(u.pm * BM + row) * 4 + u.pn), (a[0] + a[1]) + (a[2] + a[3]), __ATOMIC_RELAXED, __HIP_MEMORY_SCOPE_AGENT); }
        asm volatile("s_waitcnt vmcnt(0)" ::: "memory");
        if (lane == 0) __hip_atomic_fetch_add(cnt + 64 * u.pm, 1u, __ATOMIC_RELAXED, __HIP_MEMORY_SCOPE_AGENT);
        if (wid == 0) {
            for (unsigned sp = 0; sp < (1u << 22); ++sp) {
                if ((unsigned)__builtin_amdgcn_readfirstlane(__hip_atomic_load(cnt + 64 * u.pm, __ATOMIC_RELAXED, __HIP_MEMORY_SCOPE_AGENT)) >= 32u) break;
                __builtin_amdgcn_s_sleep(2); }
            __builtin_amdgcn_fence(__ATOMIC_ACQUIRE, "agent");
        }
        asm volatile("s_waitcnt vmcnt(0) lgkmcnt(0)" ::: "memory"); __builtin_amdgcn_s_barrier(); asm volatile("" ::: "memory");
        if (lane < 32) { const float* slot = xbuf + (size_t)(u.pm * BM + row) * 4; float q = 0.f;
#pragma unroll
            for (int t = 0; t < 4; ++t) q += __hip_atomic_load(slot + t, __ATOMIC_RELAXED, __HIP_MEMORY_SCOPE_AGENT);
            S[row] = 1.0f / sqrtf(q * (1.0f / 1024.0f) + eps); }
        asm volatile("s_waitcnt vmcnt(0) lgkmcnt(0)" ::: "memory"); __builtin_amdgcn_s_barrier(); asm volatile("" ::: "memory");
    }
};
template <bool FINAL> struct EpiResNorm {
    static constexpr bool PERM = true, AFTER_DRAIN = true;
    const float* base; float* out; const float* gate; int ldc; PanelRms st; const float* nw; const float* modn; bf16_t* Hn; bf16_t* x1b;
    __device__ __forceinline__ void operator()(const f32x4 (&)[2][2][4][2], const Unit&, int, int, int, int) const {}
    __device__ __forceinline__ void fused(f32x4 (&acc)[2][2][4][2], const Unit& u, int wr, int wc, int fr, int fq, PG8_LAS unsigned char* lds, int wid, int lane) const {
        const int row0 = u.pm * BM + wr * 64 + fr; const int b = (u.pm * BM) >> 12; const int col0 = u.pn * BM + wc * 32 + 8 * fq;
#pragma unroll
        for (int bj = 0; bj < 2; ++bj) { const int col = col0 + bj * HALF; const f32x4 g0 = *(const f32x4*)(gate + (size_t)b * 3072 + col), g1 = *(const f32x4*)(gate + (size_t)b * 3072 + col + 4);
#pragma unroll
            for (int ai = 0; ai < 2; ++ai)
#pragma unroll
                for (int m = 0; m < 4; ++m) { const size_t off = (size_t)(row0 + ai * HALF + m * 16) * ldc + col;
                    f32x4 b0, b1;
                    if (FINAL) { const u32x4 rw = *(const u32x4*)(x1b + off);
                        b0 = (f32x4){__uint_as_float(rw.x << 16), __uint_as_float(rw.x & 0xffff0000u), __uint_as_float(rw.y << 16), __uint_as_float(rw.y & 0xffff0000u)};
                        b1 = (f32x4){__uint_as_float(rw.z << 16), __uint_as_float(rw.z & 0xffff0000u), __uint_as_float(rw.w << 16), __uint_as_float(rw.w & 0xffff0000u)}; }
                    else { b0 = *(const f32x4*)(base + off); b1 = *(const f32x4*)(base + off + 4); }
                    acc[ai][bj][m][0] = b0 + g0 * acc[ai][bj][m][0]; acc[ai][bj][m][1] = b1 + g1 * acc[ai][bj][m][1];
                    asm volatile("" : "+v"(acc[ai][bj][m][0]), "+v"(acc[ai][bj][m][1]));
                    if (m == 3) asm volatile("" ::: "memory"); } }
        st.run(acc, u, wr, wc, fr, fq, lds, wid, lane);
        const PG8_LAS float* S = (const PG8_LAS float*)(lds + 4096);
#pragma unroll
        for (int bj = 0; bj < 2; ++bj) { const int col = col0 + bj * HALF;
            f32x4 w0 = *(const f32x4*)(nw + col), w1 = *(const f32x4*)(nw + col + 4), h0 = {0.f, 0.f, 0.f, 0.f}, h1 = h0;
            if (!FINAL) { const float* mb = modn + (size_t)b * 3072; w0 = w0 * (*(const f32x4*)(mb + 1024 + col) + 1.f); w1 = w1 * (*(const f32x4*)(mb + 1024 + col + 4) + 1.f); h0 = *(const f32x4*)(mb + col); h1 = *(const f32x4*)(mb + col + 4); }
#pragma unroll
            for (int ai = 0; ai < 2; ++ai)
#pragma unroll
                for (int m = 0; m < 4; ++m) { const int r = ai * HALF + wr * 64 + m * 16 + fr; const float rstd = S[r]; const size_t off = (size_t)(u.pm * BM + r) * ldc + col;
                    const f32x4 x0 = acc[ai][bj][m][0], x1 = acc[ai][bj][m][1];
                    if (FINAL) { *(f32x4*)(out + off) = x0 * rstd * w0; *(f32x4*)(out + off + 4) = x1 * rstd * w1; }
                    else { { u32x4 xw; xw.x = cvt_pk_bf16(x0[0], x0[1]); xw.y = cvt_pk_bf16(x0[2], x0[3]); xw.z = cvt_pk_bf16(x1[0], x1[1]); xw.w = cvt_pk_bf16(x1[2], x1[3]); *(u32x4*)(x1b + off) = xw; }
                        const f32x4 y0 = x0 * rstd * w0 + h0, y1 = x1 * rstd * w1 + h1;
                        u32x4 w; w.x = cvt_pk_bf16(y0[0], y0[1]); w.y = cvt_pk_bf16(y0[2], y0[3]); w.z = cvt_pk_bf16(y1[0], y1[1]); w.w = cvt_pk_bf16(y1[2], y1[3]);
                        *(u32x4*)(Hn + off) = w; }
                    if (m & 1) asm volatile("" ::: "memory"); } }
    }
};
}
namespace att {
#define LAS3 __attribute__((address_space(3)))
typedef unsigned short bf16_t;
typedef short bf16x8 __attribute__((ext_vector_type(8)));
typedef short s16x4 __attribute__((ext_vector_type(4)));
typedef float f32x16 __attribute__((ext_vector_type(16)));
typedef float f32x4 __attribute__((ext_vector_type(4)));
typedef unsigned u32x4 __attribute__((ext_vector_type(4)));
typedef float f32x2_t __attribute__((ext_vector_type(2)));
typedef __bf16 bf16x2_t __attribute__((ext_vector_type(2)));
constexpr int KSLOT = 14336, VSLOT = 8192;
constexpr int L_K = 0, L_V = 2 * KSLOT, L_WS = L_V + 2 * VSLOT, L_OST = L_WS + 8 * 256, L_BYTES = L_OST + 8 * 4096;
__device__ __forceinline__ int crow(int r, int hi) { return (r & 3) + 8 * (r >> 2) + 4 * hi; }
__device__ __forceinline__ unsigned cvtpk(float lo, float hi) { f32x2_t v = {lo, hi}; bf16x2_t b = __builtin_convertvector(v, bf16x2_t); return __builtin_bit_cast(unsigned, b); }
__device__ __forceinline__ float bflo(unsigned u) { return __uint_as_float(u << 16); }
__device__ __forceinline__ float bfhi(unsigned u) { return __uint_as_float(u & 0xffff0000u); }
__device__ __forceinline__ s16x4 vtr(const LAS3 char* p) { return __builtin_bit_cast(s16x4, __builtin_amdgcn_ds_read_tr16_b64_v4i16((LAS3 s16x4*)p)); }
__device__ __forceinline__ float swapmax(float m) { auto rr = __builtin_amdgcn_permlane32_swap(__float_as_uint(m), __float_as_uint(m), false, false); return fmaxf(__uint_as_float(rr[0]), __uint_as_float(rr[1])); }
__device__ __forceinline__ float swapsum(float m) { auto rr = __builtin_amdgcn_permlane32_swap(__float_as_uint(m), __float_as_uint(m), false, false); return __uint_as_float(rr[0]) + __uint_as_float(rr[1]); }
__device__ __forceinline__ float silu_f(float g) { return g * __builtin_amdgcn_rcpf(1.f + __builtin_amdgcn_exp2f(-1.4426950408889634f * g)); }

__device__ __forceinline__ void glds16s(const void* sbase, unsigned voff, unsigned lds_dst) { unsigned keep;
    asm volatile("s_mov_b32 %0, m0\n\ts_mov_b32 m0, %3\n\ts_nop 0\n\tglobal_load_lds_dwordx4 %1, %2\n\ts_mov_b32 m0, %0" : "=&s"(keep) : "v"(voff), "s"(sbase), "s"(lds_dst) : "memory"); }
}
namespace att2 {
using namespace att;
constexpr int M_K = 0, M_V = 2 * KSLOT, M_WS = M_V + 2 * VSLOT, M_OST = M_WS + 8 * 512, M_BYTES = M_OST + 8 * 8192;
__device__ __forceinline__ void softmax_half(f32x16& p0, f32x16& p1, float& m, float& l, f32x16& o0, f32x16& o1, LAS3 float* wsf, u32x4 (&pw)[4], int hi, int r32) {
    float ra = fmaxf(fmaxf(p0[0], p0[1]), p1[0]), rb = fmaxf(fmaxf(p0[2], p0[3]), p1[1]); ra = fmaxf(fmaxf(ra, p1[2]), p1[3]);
#pragma unroll
    for (int r = 4; r < 16; r += 4) { ra = fmaxf(fmaxf(ra, p0[r]), p0[r + 1]); rb = fmaxf(fmaxf(rb, p0[r + 2]), p0[r + 3]); ra = fmaxf(fmaxf(ra, p1[r]), p1[r + 1]); rb = fmaxf(fmaxf(rb, p1[r + 2]), p1[r + 3]); }
    const float rm = swapmax(fmaxf(ra, rb));
    const float mn = fmaxf(m, rm);
    if (__any(rm > m + 8.0f)) {
        const float alpha = __builtin_amdgcn_exp2f(m - mn);
        l *= alpha; m = mn;
        if (hi == 0) wsf[r32] = alpha;
        asm volatile("s_waitcnt lgkmcnt(0)" ::: "memory");
#pragma unroll
        for (int r4 = 0; r4 < 4; ++r4) { const f32x4 al = *(const LAS3 f32x4*)(wsf + 8 * r4 + 4 * hi);
#pragma unroll
            for (int e = 0; e < 4; ++e) { o0[4 * r4 + e] *= al[e]; o1[4 * r4 + e] *= al[e]; } }
        asm volatile("s_waitcnt lgkmcnt(0)" ::: "memory");
    }
    float s0 = 0.f, s1 = 0.f;
#pragma unroll
    for (int r = 0; r < 16; ++r) { p0[r] = __builtin_amdgcn_exp2f(p0[r] - m); p1[r] = __builtin_amdgcn_exp2f(p1[r] - m); s0 += p0[r]; s1 += p1[r]; }
    l += s0 + s1;
#pragma unroll
    for (int e = 0; e < 4; ++e) { pw[0][e] = cvtpk(p0[2 * e], p0[2 * e + 1]); pw[1][e] = cvtpk(p0[8 + 2 * e], p0[8 + 2 * e + 1]);
                                  pw[2][e] = cvtpk(p1[2 * e], p1[2 * e + 1]); pw[3][e] = cvtpk(p1[8 + 2 * e], p1[8 + 2 * e + 1]); }
}
__device__ __forceinline__ void rope_q(bf16x8& q1, bf16x8& q2, const float2* rp) {
    const u32x4 x1 = __builtin_bit_cast(u32x4, q1), x2 = __builtin_bit_cast(u32x4, q2); u32x4 y1, y2;
#pragma unroll
    for (int e = 0; e < 4; ++e) { const float2 c0 = rp[2 * e], c1 = rp[2 * e + 1];
        const float a0 = bflo(x1[e]), a1 = bfhi(x1[e]), b0 = bflo(x2[e]), b1 = bfhi(x2[e]);
        y1[e] = cvtpk(a0 * c0.x - b0 * c0.y, a1 * c1.x - b1 * c1.y); y2[e] = cvtpk(a0 * c0.y + b0 * c0.x, a1 * c1.y + b1 * c1.x); }
    q1 = __builtin_bit_cast(bf16x8, y1); q2 = __builtin_bit_cast(bf16x8, y2);
}
__device__ __forceinline__ void stage_half(const f32x16& o0, const f32x16& o1, float l, LAS3 float* wsf, LAS3 bf16_t* stg, int hi, int r32) {
    l = swapsum(l);
    if (hi == 0) wsf[32 + r32] = l;
    asm volatile("s_waitcnt lgkmcnt(0)" ::: "memory");
#pragma unroll
    for (int r4 = 0; r4 < 4; ++r4) { const f32x4 lv = *(const LAS3 f32x4*)(wsf + 32 + 8 * r4 + 4 * hi);
#pragma unroll
        for (int e = 0; e < 4; ++e) { const int r = 4 * r4 + e; const float rl = __builtin_amdgcn_rcpf(lv[e]); const int orow = crow(r, hi);
            stg[orow * 64 + r32] = (bf16_t)(cvtpk(o0[r] * rl, 0.f) & 0xffffu); stg[orow * 64 + 32 + r32] = (bf16_t)(cvtpk(o1[r] * rl, 0.f) & 0xffffu); } }
}
__device__ __forceinline__ void qproc_a(bf16x8 (&q)[4], const float* g, const float2* rope, int pos_seq, int hi, float osc) {
    float x[4][8]; float ss = 0.f;
#pragma unroll
    for (int d0 = 0; d0 < 4; ++d0) { const u32x4 u = __builtin_bit_cast(u32x4, q[d0]);
#pragma unroll
        for (int e = 0; e < 4; ++e) { x[d0][2 * e] = bflo(u[e]); x[d0][2 * e + 1] = bfhi(u[e]); ss += x[d0][2 * e] * x[d0][2 * e] + x[d0][2 * e + 1] * x[d0][2 * e + 1]; } }
    ss = swapsum(ss);
    const float rstd = 1.0f / sqrtf(ss * (1.0f / 64.0f) + 1e-6f);
    const float2* rr = rope + (size_t)(pos_seq >> 6) * 16 + 8 * hi; const float2* rc = rope + (size_t)(pos_seq & 63) * 16 + 8 * hi;
#pragma unroll
    for (int d0 = 0; d0 < 4; ++d0)
#pragma unroll
        for (int e = 0; e < 8; ++e) x[d0][e] *= rstd * g[16 * d0 + 8 * hi + e];
    u32x4 y[4];
#pragma unroll
    for (int e = 0; e < 4; ++e) { float a[2], b[2], c[2], d[2];
#pragma unroll
        for (int k = 0; k < 2; ++k) { const float2 cr = rr[2 * e + k], cc = rc[2 * e + k]; const float x1 = x[0][2 * e + k], x2 = x[1][2 * e + k], z1 = x[2][2 * e + k], z2 = x[3][2 * e + k];
            a[k] = (x1 * cr.x - x2 * cr.y) * osc; b[k] = (x1 * cr.y + x2 * cr.x) * osc; c[k] = (z1 * cc.x - z2 * cc.y) * osc; d[k] = (z1 * cc.y + z2 * cc.x) * osc; }
        y[0][e] = cvtpk(a[0], a[1]); y[1][e] = cvtpk(b[0], b[1]); y[2][e] = cvtpk(c[0], c[1]); y[3][e] = cvtpk(d[0], d[1]); }
#pragma unroll
    for (int d0 = 0; d0 < 4; ++d0) q[d0] = __builtin_bit_cast(bf16x8, y[d0]);
}
__device__ __forceinline__ void softmax_rel(f32x16& p0, f32x16& p1, float& m, float& l, f32x16& o0, f32x16& o1, LAS3 float* wsf, u32x4 (&pw)[4], bool first, int hi, int r32) {
    float ra = fmaxf(fmaxf(p0[0], p0[1]), p1[0]), rb = fmaxf(fmaxf(p0[2], p0[3]), p1[1]); ra = fmaxf(fmaxf(ra, p1[2]), p1[3]);
#pragma unroll
    for (int r = 4; r < 16; r += 4) { ra = fmaxf(fmaxf(ra, p0[r]), p0[r + 1]); rb = fmaxf(fmaxf(rb, p0[r + 2]), p0[r + 3]); ra = fmaxf(fmaxf(ra, p1[r]), p1[r + 1]); rb = fmaxf(fmaxf(rb, p1[r + 2]), p1[r + 3]); }
    const float rm = swapmax(fmaxf(ra, rb));
    if (first || __any(rm > 8.0f)) {
        const float mt = m + (first ? rm : fmaxf(rm, 0.f));
        const unsigned mb = cvtpk(mt, 0.f) & 0xffffu; const float mn = __uint_as_float(mb << 16);
        const float delta = mn - m;
#pragma unroll
        for (int r = 0; r < 16; ++r) { p0[r] -= delta; p1[r] -= delta; }
        const float alpha = first ? 1.f : __builtin_amdgcn_exp2f(-delta);
        l *= alpha; m = mn;
        if (hi == 0) wsf[r32] = alpha;
        asm volatile("s_waitcnt lgkmcnt(0)" ::: "memory");
#pragma unroll
        for (int r4 = 0; r4 < 4; ++r4) { const f32x4 al = *(const LAS3 f32x4*)(wsf + 8 * r4 + 4 * hi);
#pragma unroll
            for (int e = 0; e < 4; ++e) { o0[4 * r4 + e] *= al[e]; o1[4 * r4 + e] *= al[e]; } }
        asm volatile("s_waitcnt lgkmcnt(0)" ::: "memory");
    }
    float s0 = 0.f, s1 = 0.f;
#pragma unroll
    for (int r = 0; r < 16; ++r) { p0[r] = __builtin_amdgcn_exp2f(p0[r]); p1[r] = __builtin_amdgcn_exp2f(p1[r]); s0 += p0[r]; s1 += p1[r]; }
    l += s0 + s1;
#pragma unroll
    for (int e = 0; e < 4; ++e) { pw[0][e] = cvtpk(p0[2 * e], p0[2 * e + 1]); pw[1][e] = cvtpk(p0[8 + 2 * e], p0[8 + 2 * e + 1]);
                                  pw[2][e] = cvtpk(p1[2 * e], p1[2 * e + 1]); pw[3][e] = cvtpk(p1[8 + 2 * e], p1[8 + 2 * e + 1]); }
}
template <int DQK, int MODE>
__device__ __forceinline__ void attn_unit(LAS3 unsigned char* lds, const bf16_t* aQ, const bf16_t* aK, const bf16_t* aK2, const bf16_t* aV, const bf16_t* aG, bf16_t* aO,
                                          const int a_qp, const int a_kp, const int a_k2p, const int a_vp, const int a_gp, const int a_op, const int a_q0, const int a_t_lo, const int a_t_hi,
                                          const float a_slope2, const float a_sink2, const float2* aRope, const float* aQn = nullptr) {
    constexpr int ND = DQK / 16;
    const int tid = threadIdx.x, lane = tid & 63, r32 = lane & 31, hi = lane >> 5; const int wid = __builtin_amdgcn_readfirstlane(tid >> 6);
    const int qw = a_q0 + wid * 64;
    bf16x8 qA[ND], qB[ND];
    { const bf16_t* Qw = aQ + (size_t)(qw + r32) * a_qp + hi * 8;
#pragma unroll
      for (int d0 = 0; d0 < ND; ++d0) { qA[d0] = *(const bf16x8*)(Qw + d0 * 16); qB[d0] = *(const bf16x8*)(Qw + (size_t)32 * a_qp + d0 * 16); } }
    if (DQK == 96) { rope_q(qA[ND - 2], qA[ND - 1], aRope + (size_t)(qw + r32) * 16 + 8 * hi); rope_q(qB[ND - 2], qB[ND - 1], aRope + (size_t)(qw + 32 + r32) * 16 + 8 * hi); }
    if constexpr (DQK == 64) { if (aQn) {
        qproc_a(qA, aQn, aRope, qw + r32, hi, 0.125f * 1.4426950408889634f);
#pragma unroll
        for (int d0 = 0; d0 < 4; ++d0) asm volatile("" : "+v"(qA[d0]));
        asm volatile("" ::: "memory");
        qproc_a(qB, aQn, aRope, qw + 32 + r32, hi, 0.125f * 1.4426950408889634f);
#pragma unroll
        for (int d0 = 0; d0 < 4; ++d0) asm volatile("" : "+v"(qB[d0]));
        asm volatile("" ::: "memory"); } }
    const unsigned koffg = (unsigned)(lane * a_kp + wid * 8) * 2u, k2offg = (unsigned)(lane * a_k2p + (wid & 3) * 8) * 2u, voffg = (unsigned)((16 * (wid & 3) + (lane >> 2)) * a_vp + (wid >> 2) * 32 + (lane & 3) * 8) * 2u;
    const unsigned lds0 = (unsigned)(uintptr_t)lds;
    const unsigned kdst = (unsigned)__builtin_amdgcn_readfirstlane(lds0 + M_K + wid * 1024), vdst = (unsigned)__builtin_amdgcn_readfirstlane(lds0 + M_V + wid * 1024);
    LAS3 float* wsfA = (LAS3 float*)(lds + M_WS + wid * 512); LAS3 float* wsfB = wsfA + 64;
#define AT_DMA(t, buf) do { glds16s(aK + (size_t)(t) * 64 * a_kp, koffg, kdst + (buf) * KSLOT); \
        if (DQK == 96 && wid < 4) glds16s(aK2 + (size_t)(t) * 64 * a_k2p, k2offg, kdst + (buf) * KSLOT + 8192); \
        glds16s(aV + (size_t)(t) * 64 * a_vp, voffg, vdst + (buf) * VSLOT); } while (0)
    float mA = (MODE == 1) ? a_sink2 : 0.f, mB = mA;
    float lA = (MODE == 1 && hi == 0) ? 1.f : 0.f, lB = lA;
    f32x16 oA0, oA1, oB0, oB1;
#pragma unroll
    for (int r = 0; r < 16; ++r) { oA0[r] = 0.f; oA1[r] = 0.f; oB0[r] = 0.f; oB1[r] = 0.f; }
    if (MODE == 0) {
        if (tid < 256) { const int bufi = tid >> 7, ch = (tid >> 6) & 1, row = tid & 63; const u32x4 one = {0x00003F80u, 0u, 0u, 0u}, zero = {0u, 0u, 0u, 0u};
            *(LAS3 u32x4*)(lds + M_K + bufi * KSLOT + (2 * ND + ch) * 1024 + row * 16) = ch ? zero : one; } }
    AT_DMA(a_t_lo, 0);
#pragma unroll
    for (int d0 = 0; d0 < ND; ++d0) asm volatile("" : "+v"(qA[d0]), "+v"(qB[d0]));
    asm volatile("s_waitcnt vmcnt(0)" ::: "memory"); __syncthreads();
    const int koff = hi * 1024 + r32 * 16;
    const int voff = ((lane >> 4) & 1) * 32 + (lane & 3) * 8 + (4 * hi + ((lane & 15) >> 2)) * 64;
    for (int t = a_t_lo; t < a_t_hi; ++t) {
        const int cur = (t - a_t_lo) & 1;
        if (t + 1 < a_t_hi) AT_DMA(t + 1, cur ^ 1);
        bool active = true;
        if (MODE == 1) { const int k0 = t * 64; active = (k0 + 63 >= qw - 128) && (k0 <= qw + 63 + 128); }
        if (active) {
            f32x16 pA0, pA1, pB0, pB1;
#pragma unroll
            for (int r = 0; r < 16; ++r) { pA0[r] = 0.f; pA1[r] = 0.f; pB0[r] = 0.f; pB1[r] = 0.f; }
            const LAS3 char* kb = (const LAS3 char*)(lds + M_K + cur * KSLOT + koff);
#pragma unroll
            for (int d0 = 0; d0 < ND; ++d0) {
                const bf16x8 b0 = *(const LAS3 bf16x8*)(kb + d0 * 2048), b1 = *(const LAS3 bf16x8*)(kb + d0 * 2048 + 512);
                pA0 = __builtin_amdgcn_mfma_f32_32x32x16_bf16(b0, qA[d0], pA0, 0, 0, 0);
                pA1 = __builtin_amdgcn_mfma_f32_32x32x16_bf16(b1, qA[d0], pA1, 0, 0, 0);
                pB0 = __builtin_amdgcn_mfma_f32_32x32x16_bf16(b0, qB[d0], pB0, 0, 0, 0);
                pB1 = __builtin_amdgcn_mfma_f32_32x32x16_bf16(b1, qB[d0], pB1, 0, 0, 0);
            }
            if (MODE == 0) {
                const bf16x8 b0 = *(const LAS3 bf16x8*)(kb + ND * 2048), b1 = *(const LAS3 bf16x8*)(kb + ND * 2048 + 512);
                const u32x4 qxA = {hi == 0 ? (__float_as_uint(-mA) >> 16) : 0u, 0u, 0u, 0u}, qxB = {hi == 0 ? (__float_as_uint(-mB) >> 16) : 0u, 0u, 0u, 0u};
                const bf16x8 fa = __builtin_bit_cast(bf16x8, qxA), fb = __builtin_bit_cast(bf16x8, qxB);
                pA0 = __builtin_amdgcn_mfma_f32_32x32x16_bf16(b0, fa, pA0, 0, 0, 0); pA1 = __builtin_amdgcn_mfma_f32_32x32x16_bf16(b1, fa, pA1, 0, 0, 0);
                pB0 = __builtin_amdgcn_mfma_f32_32x32x16_bf16(b0, fb, pB0, 0, 0, 0); pB1 = __builtin_amdgcn_mfma_f32_32x32x16_bf16(b1, fb, pB1, 0, 0, 0);
            }
            if (MODE == 1) { const int rel0 = t * 64 + 4 * hi - (qw + r32);
#pragma unroll
                for (int r = 0; r < 16; ++r) { const int d = rel0 + (r & 3) + 8 * (r >> 2);
                    const int a0 = d < 0 ? -d : d, a1 = (d + 32) < 0 ? -(d + 32) : (d + 32), a2 = (d - 32) < 0 ? -(d - 32) : (d - 32);
                    pA0[r] = (a0 <= 128) ? pA0[r] - a_slope2 * (float)a0 : -INFINITY; pA1[r] = (a1 <= 128) ? pA1[r] - a_slope2 * (float)a1 : -INFINITY;
                    pB0[r] = (a2 <= 128) ? pB0[r] - a_slope2 * (float)a2 : -INFINITY; pB1[r] = (a0 <= 128) ? pB1[r] - a_slope2 * (float)a0 : -INFINITY; } }
            u32x4 pwA[4], pwB[4];
            if (MODE == 0) { softmax_rel(pA0, pA1, mA, lA, oA0, oA1, wsfA, pwA, t == a_t_lo, hi, r32); softmax_rel(pB0, pB1, mB, lB, oB0, oB1, wsfB, pwB, t == a_t_lo, hi, r32); }
            else { softmax_half(pA0, pA1, mA, lA, oA0, oA1, wsfA, pwA, hi, r32); softmax_half(pB0, pB1, mB, lB, oB0, oB1, wsfB, pwB, hi, r32); }
            const LAS3 char* vb = (const LAS3 char*)(lds + M_V + cur * VSLOT + voff);
#pragma unroll
            for (int ks = 0; ks < 4; ++ks) {
                const s16x4 a0 = vtr(vb + ks * 1024), a1 = vtr(vb + ks * 1024 + 512), c0 = vtr(vb + 4096 + ks * 1024), c1 = vtr(vb + 4096 + ks * 1024 + 512);
                const bf16x8 v0 = {a0[0], a0[1], a0[2], a0[3], a1[0], a1[1], a1[2], a1[3]}, v1 = {c0[0], c0[1], c0[2], c0[3], c1[0], c1[1], c1[2], c1[3]};
                const bf16x8 pa = __builtin_bit_cast(bf16x8, pwA[ks]), pb = __builtin_bit_cast(bf16x8, pwB[ks]);
                oA0 = __builtin_amdgcn_mfma_f32_32x32x16_bf16(pa, v0, oA0, 0, 0, 0);
                oA1 = __builtin_amdgcn_mfma_f32_32x32x16_bf16(pa, v1, oA1, 0, 0, 0);
                oB0 = __builtin_amdgcn_mfma_f32_32x32x16_bf16(pb, v0, oB0, 0, 0, 0);
                oB1 = __builtin_amdgcn_mfma_f32_32x32x16_bf16(pb, v1, oB1, 0, 0, 0);
            }
        }
        asm volatile("s_waitcnt vmcnt(0)" ::: "memory"); __syncthreads();
    }
    LAS3 bf16_t* stg = (LAS3 bf16_t*)(lds + M_OST + wid * 8192);
    stage_half(oA0, oA1, lA, wsfA, stg, hi, r32);
    stage_half(oB0, oB1, lB, wsfB, stg + 32 * 64, hi, r32);
    asm volatile("s_waitcnt lgkmcnt(0)" ::: "memory");
#pragma unroll
    for (int i = 0; i < 8; ++i) { const int row = i * 8 + (lane >> 3), ch = lane & 7;
        const u32x4 ov = *(const LAS3 u32x4*)(stg + row * 64 + ch * 8);
        const u32x4 gv = *(const u32x4*)(aG + (size_t)(qw + row) * a_gp + ch * 8);
        u32x4 w;
#pragma unroll
        for (int e = 0; e < 4; ++e) w[e] = cvtpk(bflo(ov[e]) * silu_f(bflo(gv[e])), bfhi(ov[e]) * silu_f(bfhi(gv[e])));
        *(u32x4*)(aO + (size_t)(qw + row) * a_op + ch * 8) = w; }
    asm volatile("s_waitcnt lgkmcnt(0)" ::: "memory");
#undef AT_DMA
}
}
namespace att6 {
using namespace att;
constexpr int TSLOT = 16384;
constexpr int X_R = 0, X_WS = 5 * TSLOT, X_OST = X_WS + 8 * 512, X_BYTES = X_OST + 8 * 4096;
__device__ __forceinline__ void attn_unit_win(LAS3 unsigned char* lds, const bf16_t* aQ, const bf16_t* aK, const bf16_t* aV, const bf16_t* aG, bf16_t* aO,
                                              const int pitch, const int a_op, const int a_q0, const int tile0  , const int ntiles_seq,
                                              const float slopeA, const float sinkA, const float slopeB, const float sinkB) {
    const int tid = threadIdx.x, lane = tid & 63, r32 = lane & 31, hi = lane >> 5; const int wid = __builtin_amdgcn_readfirstlane(tid >> 6);
    const int qw = a_q0 + wid * 32;
    const unsigned koffg = (unsigned)(lane * pitch + wid * 8) * 2u, voffg = (unsigned)((16 * (wid & 3) + (lane >> 2)) * pitch + (wid >> 2) * 32 + (lane & 3) * 8) * 2u;
    const unsigned lds0 = (unsigned)(uintptr_t)lds;
    const unsigned kdst = (unsigned)__builtin_amdgcn_readfirstlane(lds0 + X_R + wid * 1024), vdst = kdst + 8192u;
#define A6_DMA(j) do { int tt_ = tile0 + (j); tt_ = tt_ < 0 ? 0 : (tt_ >= ntiles_seq ? ntiles_seq - 1 : tt_); const unsigned so_ = (unsigned)(((j) % 5) * TSLOT); \
        glds16s(aK + (size_t)tt_ * 64 * pitch, koffg, kdst + so_); glds16s(aV + (size_t)tt_ * 64 * pitch, voffg, vdst + so_); } while (0)
    A6_DMA(0); A6_DMA(1); A6_DMA(2); A6_DMA(3);
    bf16x8 qA[4], qB[4];
    { const bf16_t* Qw = aQ + (size_t)(qw + r32) * pitch + hi * 8;
#pragma unroll
      for (int d0 = 0; d0 < 4; ++d0) { qA[d0] = *(const bf16x8*)(Qw + d0 * 16); qB[d0] = *(const bf16x8*)(Qw + 64 + d0 * 16); } }
#pragma unroll
    for (int d0 = 0; d0 < 4; ++d0) asm volatile("" : "+v"(qA[d0]), "+v"(qB[d0]));
    LAS3 float* wsfA = (LAS3 float*)(lds + X_WS + wid * 512); LAS3 float* wsfB = wsfA + 64;
    float mA = sinkA, mB = sinkB, lA = (hi == 0) ? 1.f : 0.f, lB = lA;
    f32x16 oA0, oA1, oB0, oB1;
#pragma unroll
    for (int r = 0; r < 16; ++r) { oA0[r] = 0.f; oA1[r] = 0.f; oB0[r] = 0.f; oB1[r] = 0.f; }
    const int koff = hi * 1024 + r32 * 16;
    const int voff = 8192 + ((lane >> 4) & 1) * 32 + (lane & 3) * 8 + (4 * hi + ((lane & 15) >> 2)) * 64;
    asm volatile("s_waitcnt vmcnt(0) lgkmcnt(0)\n\ts_barrier" ::: "memory");
#pragma unroll 1
    for (int s = 0; s < 5; ++s) {
        if (s < 4) { int tt_ = tile0 + s + 4; tt_ = tt_ < 0 ? 0 : (tt_ >= ntiles_seq ? ntiles_seq - 1 : tt_); const unsigned so_ = (unsigned)((s == 0 ? 4 : s - 1) * TSLOT);
            glds16s(aK + (size_t)tt_ * 64 * pitch, koffg, kdst + so_); glds16s(aV + (size_t)tt_ * 64 * pitch, voffg, vdst + so_); }
        const int j = (wid >> 1) + s;
        const int t = tile0 + j; const int k0 = t * 64;
        const int slot = (j >= 5 ? j - 5 : j) * TSLOT;
        if (t >= 0 && t < ntiles_seq) {
            f32x16 pA0, pA1, pB0, pB1;
#pragma unroll
            for (int r = 0; r < 16; ++r) { pA0[r] = 0.f; pA1[r] = 0.f; pB0[r] = 0.f; pB1[r] = 0.f; }
            const LAS3 char* kb = (const LAS3 char*)(lds + X_R + slot + koff);
#pragma unroll
            for (int d0 = 0; d0 < 4; ++d0) {
                const bf16x8 b0 = *(const LAS3 bf16x8*)(kb + d0 * 2048), b1 = *(const LAS3 bf16x8*)(kb + d0 * 2048 + 512);
                pA0 = __builtin_amdgcn_mfma_f32_32x32x16_bf16(b0, qA[d0], pA0, 0, 0, 0); pA1 = __builtin_amdgcn_mfma_f32_32x32x16_bf16(b1, qA[d0], pA1, 0, 0, 0);
                pB0 = __builtin_amdgcn_mfma_f32_32x32x16_bf16(b0, qB[d0], pB0, 0, 0, 0); pB1 = __builtin_amdgcn_mfma_f32_32x32x16_bf16(b1, qB[d0], pB1, 0, 0, 0);
            }
            { const float fd0 = (float)(k0 + 4 * hi - (qw + r32));
#pragma unroll
              for (int r = 0; r < 16; ++r) { const float t0 = fd0 + (float)((r & 3) + 8 * (r >> 2)), t1 = t0 + 32.f;
                  pA0[r] = __builtin_fmaf(-slopeA, __builtin_fabsf(t0), pA0[r]); pA1[r] = __builtin_fmaf(-slopeA, __builtin_fabsf(t1), pA1[r]);
                  pB0[r] = __builtin_fmaf(-slopeB, __builtin_fabsf(t0), pB0[r]); pB1[r] = __builtin_fmaf(-slopeB, __builtin_fabsf(t1), pB1[r]);
                  if (s == 0 || s == 4) { const bool in0 = __builtin_fabsf(t0) <= 128.f, in1 = __builtin_fabsf(t1) <= 128.f;
                      pA0[r] = in0 ? pA0[r] : -INFINITY; pA1[r] = in1 ? pA1[r] : -INFINITY; pB0[r] = in0 ? pB0[r] : -INFINITY; pB1[r] = in1 ? pB1[r] : -INFINITY; } } }
            u32x4 pwA[4], pwB[4];
            att2::softmax_half(pA0, pA1, mA, lA, oA0, oA1, wsfA, pwA, hi, r32);
            att2::softmax_half(pB0, pB1, mB, lB, oB0, oB1, wsfB, pwB, hi, r32);
            const LAS3 char* vb = (const LAS3 char*)(lds + X_R + slot + voff);
#pragma unroll
            for (int ks = 0; ks < 4; ++ks) {
                const s16x4 a0 = vtr(vb + ks * 1024), a1 = vtr(vb + ks * 1024 + 512), c0 = vtr(vb + 4096 + ks * 1024), c1 = vtr(vb + 4096 + ks * 1024 + 512);
                const bf16x8 v0 = {a0[0], a0[1], a0[2], a0[3], a1[0], a1[1], a1[2], a1[3]}, v1 = {c0[0], c0[1], c0[2], c0[3], c1[0], c1[1], c1[2], c1[3]};
                const bf16x8 pa = __builtin_bit_cast(bf16x8, pwA[ks]), pb = __builtin_bit_cast(bf16x8, pwB[ks]);
                oA0 = __builtin_amdgcn_mfma_f32_32x32x16_bf16(pa, v0, oA0, 0, 0, 0); oA1 = __builtin_amdgcn_mfma_f32_32x32x16_bf16(pa, v1, oA1, 0, 0, 0);
                oB0 = __builtin_amdgcn_mfma_f32_32x32x16_bf16(pb, v0, oB0, 0, 0, 0); oB1 = __builtin_amdgcn_mfma_f32_32x32x16_bf16(pb, v1, oB1, 0, 0, 0);
            }
        }
        asm volatile("s_waitcnt vmcnt(0) lgkmcnt(0)\n\ts_barrier" ::: "memory");
    }
    LAS3 bf16_t* stg = (LAS3 bf16_t*)(lds + X_OST + wid * 4096);
#pragma unroll
    for (int hd = 0; hd < 2; ++hd) {
        if (hd == 0) att2::stage_half(oA0, oA1, lA, wsfA, stg, hi, r32); else att2::stage_half(oB0, oB1, lB, wsfB, stg, hi, r32);
        asm volatile("s_waitcnt lgkmcnt(0)" ::: "memory");
#pragma unroll
        for (int i = 0; i < 4; ++i) { const int row = i * 8 + (lane >> 3), ch = lane & 7;
            const u32x4 ov = *(const LAS3 u32x4*)(stg + row * 64 + ch * 8);
            const u32x4 gv = *(const u32x4*)(aG + (size_t)(qw + row) * pitch + hd * 64 + ch * 8);
            u32x4 w;
#pragma unroll
            for (int e = 0; e < 4; ++e) w[e] = cvtpk(bflo(ov[e]) * silu_f(bflo(gv[e])), bfhi(ov[e]) * silu_f(bfhi(gv[e])));
            *(u32x4*)(aO + (size_t)(qw + row) * a_op + hd * 64 + ch * 8) = w; }
        asm volatile("s_waitcnt vmcnt(0) lgkmcnt(0)" ::: "memory");
    }
#undef A6_DMA
}
}
#define GAS __attribute__((address_space(1)))
#define LAS __attribute__((address_space(3)))
typedef unsigned short bf16;
typedef unsigned v4u __attribute__((ext_vector_type(4)));
typedef unsigned v2u __attribute__((ext_vector_type(2)));
typedef float f32x4 __attribute__((ext_vector_type(4)));
constexpr int DM = 1024, NBATCH = 4, SEQ = 4096, TOK = NBATCH * SEQ;
constexpr int N0 = 2304, N0_REAL = 2208, N1 = 2560;
constexpr int C_QA = 0, C_KA = 512, C_VA = 640, C_GA = 768, C_CQ = 1280, C_CKV = 1536, C_KR = 1664, C_GB = 1696;
constexpr int C_QC = 0, C_KC = 1024, C_VC = 1280, C_GC = 1536;
constexpr float EPS = 1e-6f, LOG2E = 1.4426950408889634f;
constexpr float C2A = 0.125f * LOG2E;
constexpr float C2B = 0.10206207261596577f * LOG2E;
constexpr size_t MiB = 1u << 20;
constexpr size_t WS_CTL = 0, CTL_ZERO_BYTES = 49152;
constexpr size_t WS_CNT6 = 16384, WS_CNT10 = 32768, WS_XB6 = 256 * 1024, WS_XB10 = 512 * 1024;
constexpr size_t WS_MOD = 1 * MiB, WS_ROPE = 1 * MiB + 256 * 1024;
constexpr size_t WS_WIN0 = 2 * MiB, WS_WOUT0 = 7 * MiB, WS_WIN1 = 9 * MiB, WS_WOUT1 = 14 * MiB, WS_WUQ = 16 * MiB, WS_WUKV = 16 * MiB + 512 * 1024;
constexpr size_t WS_H = 32 * MiB, WS_P = 64 * MiB, WS_QB = 144 * MiB, WS_KVB = 168 * MiB, WS_MIX = 200 * MiB, WS_CQN = 232 * MiB, WS_CKVN = 240 * MiB, WS_END = 244 * MiB;
constexpr int LDS_BYTES = 147456;
static_assert(att2::M_BYTES <= 131072 && att6::X_BYTES <= LDS_BYTES - 64, "attention LDS");

struct Params {
    const float *x, *c, *norm_w, *ada_w, *ada_b, *even_w_in, *a_q_norm, *a_k_norm, *b_q_lora_norm, *b_kv_lora_norm, *b_w_uq, *b_w_uk, *b_w_uv, *even_w_out, *odd_w_in, *c_sink, *odd_w_out, *final_norm;
    float* out; unsigned char* ws;
};

__device__ __forceinline__ unsigned f2bf(float f) { unsigned u = __builtin_bit_cast(unsigned, f); return (u + 0x7fffu + ((u >> 16) & 1u)) >> 16; }
__device__ __forceinline__ unsigned pk2(float lo, float hi) { return f2bf(lo) | (f2bf(hi) << 16); }
__device__ __forceinline__ float bflo(unsigned u) { return __uint_as_float(u << 16); }
__device__ __forceinline__ float bfhi(unsigned u) { return __uint_as_float(u & 0xffff0000u); }
__device__ __forceinline__ float wave_sum(float v) {
#pragma unroll
    for (int o = 1; o < 64; o <<= 1) v += __shfl_xor(v, o);
    return v;
}
#define LDS_WAIT() asm volatile("s_waitcnt lgkmcnt(0)" ::: "memory")

__device__ __forceinline__ void transpose_item(const float* W, int K, int N, bf16* WT, int row_off, LAS float* scr, int item, int lane) {
    const int nblk = N / 32, kb = item / nblk, nb = item % nblk, k0 = 64 * kb, n0 = 32 * nb;
#pragma unroll 8
    for (int i = 0; i < 32; ++i) { const int kk = 2 * i + (lane >> 5); scr[kk * 33 + (lane & 31)] = W[(size_t)(k0 + kk) * N + n0 + (lane & 31)]; }
    LDS_WAIT(); asm volatile("" ::: "memory");
    const int c = lane & 7;
#pragma unroll
    for (int j = 0; j < 4; ++j) { const int n = (lane >> 3) + 8 * j; const LAS float* s = scr + (8 * c) * 33 + n;
        v4u o; o.x = pk2(s[0 * 33], s[1 * 33]); o.y = pk2(s[2 * 33], s[3 * 33]); o.z = pk2(s[4 * 33], s[5 * 33]); o.w = pk2(s[6 * 33], s[7 * 33]);
        *(v4u*)(WT + (size_t)(row_off + n0 + n) * K + k0 + 8 * c) = o; }
    LDS_WAIT(); asm volatile("" ::: "memory");
}

__device__ __forceinline__ void adaln_rows(const float* xin, const float* nw, const float* mod  , bf16* H, int gw, int NGW, int lane) {
    constexpr int NR = 4;
    for (int mb = gw; mb < TOK; mb += NR * NGW) {
        f32x4 v[NR][4]; float ss[NR]; int mr[NR];
#pragma unroll
        for (int r = 0; r < NR; ++r) { const int m = mb + r * NGW; mr[r] = m < TOK ? m : mb; const f32x4* xr = (const f32x4*)(xin + (size_t)mr[r] * DM) + lane;
#pragma unroll
            for (int j = 0; j < 4; ++j) v[r][j] = xr[64 * j]; }
#pragma unroll
        for (int r = 0; r < NR; ++r) { float s = 0.f;
#pragma unroll
            for (int j = 0; j < 4; ++j) s += (v[r][j].x * v[r][j].x + v[r][j].y * v[r][j].y) + (v[r][j].z * v[r][j].z + v[r][j].w * v[r][j].w);
            ss[r] = 1.f / sqrtf(wave_sum(s) * (1.f / DM) + EPS); }
#pragma unroll
        for (int j = 0; j < 4; ++j) { const int cidx = 4 * (lane + 64 * j); const f32x4 w = *(const f32x4*)(nw + cidx);
#pragma unroll
            for (int r = 0; r < NR; ++r) { if (r > 0 && mb + r * NGW >= TOK) continue; const float* mbp = mod + (size_t)(mr[r] >> 12) * 3072;
                const f32x4 sh = *(const f32x4*)(mbp + cidx), sc = *(const f32x4*)(mbp + 1024 + cidx); const f32x4 h = v[r][j] * ss[r] * w * (sc + 1.f) + sh;
                v2u o; o.x = pk2(h.x, h.y); o.y = pk2(h.z, h.w); *(v2u*)(H + (size_t)mr[r] * DM + cidx) = o; } }
    }
}

struct PostRaw { v4u k; v2u cq; unsigned ckv; unsigned r1, r2; float2 cs[8]; float2 ckr; };
__device__ __forceinline__ void post_load(PostRaw& R, const bf16* pr, int m, const float2* rope, int lane) {
    R.k = *(const v4u*)(pr + C_KA + 8 * (lane & 15)); R.cq = *(const v2u*)(pr + C_CQ + 4 * lane); R.ckv = *(const unsigned*)(pr + C_CKV + 2 * lane);
    R.r1 = pr[C_KR + (lane & 15)]; R.r2 = pr[C_KR + 16 + (lane & 15)];
    const int j = lane & 7, s = m & 4095; const float2* rp = rope + (size_t)((j < 4) ? (s >> 6) : (s & 63)) * 16 + 8 * (j & 1);
#pragma unroll
    for (int e = 0; e < 8; ++e) R.cs[e] = rp[e];
    R.ckr = rope[(size_t)s * 16 + (lane & 15)];
}
__device__ __forceinline__ v4u post_head(const v4u raw, const float* g8, const float2 (&rp)[8], int j, float osc) {
    float xv[8];
#pragma unroll
    for (int e = 0; e < 4; ++e) { xv[2 * e] = bflo(raw[e]); xv[2 * e + 1] = bfhi(raw[e]); }
    float ss = 0.f;
#pragma unroll
    for (int e = 0; e < 8; ++e) ss += xv[e] * xv[e];
    ss += __shfl_xor(ss, 1); ss += __shfl_xor(ss, 2); ss += __shfl_xor(ss, 4);
    const float rstd = 1.f / sqrtf(ss * (1.f / 64.f) + EPS);
    float y[8];
#pragma unroll
    for (int e = 0; e < 8; ++e) { const float xn = xv[e] * rstd * g8[e]; const float pt = __shfl_xor(xn, 2); const float2 cs = rp[e];
        y[e] = ((j & 2) == 0 ? xn * cs.x - pt * cs.y : pt * cs.y + xn * cs.x) * osc; }
    v4u o; o.x = pk2(y[0], y[1]); o.y = pk2(y[2], y[3]); o.z = pk2(y[4], y[5]); o.w = pk2(y[6], y[7]); return o;
}
__device__ __forceinline__ void post_compute(const PostRaw& R, int m, bf16* pr, const float* a_q_norm, const float* a_k_norm, const float* b_q_lora_norm, const float* b_kv_lora_norm,
                                             bf16* CQN, bf16* CKVN, const float2* rope, int lane) {
    const int j = lane & 7;
    const v4u ok = post_head(R.k, a_k_norm + 8 * j, R.cs, j, 1.f);
    if (lane < 16) *(v4u*)(pr + C_KA + 8 * lane) = ok;
    {
        const float a0 = bflo(R.cq.x), a1 = bfhi(R.cq.x), a2 = bflo(R.cq.y), a3 = bfhi(R.cq.y);
        const float rstd = 1.f / sqrtf(wave_sum((a0 * a0 + a1 * a1) + (a2 * a2 + a3 * a3)) * (1.f / 256.f) + EPS);
        const f32x4 g = *(const f32x4*)(b_q_lora_norm + 4 * lane);
        v2u o; o.x = pk2(a0 * rstd * g.x, a1 * rstd * g.y); o.y = pk2(a2 * rstd * g.z, a3 * rstd * g.w); *(v2u*)(CQN + (size_t)m * 256 + 4 * lane) = o;
    }
    {
        const float a0 = bflo(R.ckv), a1 = bfhi(R.ckv);
        const float rstd = 1.f / sqrtf(wave_sum(a0 * a0 + a1 * a1) * (1.f / 128.f) + EPS);
        const float2 g = *(const float2*)(b_kv_lora_norm + 2 * lane);
        *(unsigned*)(CKVN + (size_t)m * 128 + 2 * lane) = pk2(a0 * rstd * g.x, a1 * rstd * g.y);
    }
    if (lane < 16) {
        const float x1 = __uint_as_float(R.r1 << 16), x2 = __uint_as_float(R.r2 << 16);
        const float2 cs = R.ckr;
        pr[C_KR + lane] = (bf16)f2bf(x1 * cs.x - x2 * cs.y); pr[C_KR + 16 + lane] = (bf16)f2bf(x1 * cs.y + x2 * cs.x);
    }
}
__device__ __forceinline__ void post_rows(const float* a_q_norm, const float* a_k_norm, const float* b_q_lora_norm, const float* b_kv_lora_norm, bf16* P, bf16* CQN, bf16* CKVN, const float2* rope, int gw, int NGW, int lane) {
    constexpr int NR = 4;
    for (int mb = gw; mb < TOK; mb += NR * NGW) {
        PostRaw R[NR];
#pragma unroll
        for (int r = 0; r < NR; ++r) { const int m = mb + r * NGW; post_load(R[r], P + (size_t)(m < TOK ? m : mb) * N0, m < TOK ? m : mb, rope, lane); }
#pragma unroll
        for (int r = 0; r < NR; ++r) { const int m = mb + r * NGW; if (m < TOK) post_compute(R[r], m, P + (size_t)m * N0, a_q_norm, a_k_norm, b_q_lora_norm, b_kv_lora_norm, CQN, CKVN, rope, lane); }
    }
}
typedef unsigned v4u_xb;
#define RLX_AGENT __ATOMIC_RELAXED, __HIP_MEMORY_SCOPE_AGENT
#define XB_TMO      128
#define XB_XCNT(j)  (256  + 64 * (j))
#define XB_XSUB(j)  (1280 + 64 * (j))
#define XB_XGEN(j)  (2304 + 64 * (j))
#define XB_TOP      3328
#define XB_TOPGEN   3392
#define XCD_BAR_WORDS 3456
#define XB_SPIN_CAP (1u << 18)

__device__ __forceinline__ unsigned xb_ld(unsigned* p)              { return __hip_atomic_load(p, __ATOMIC_RELAXED, __HIP_MEMORY_SCOPE_AGENT); }
__device__ __forceinline__ unsigned xb_add(unsigned* p, unsigned v) { return __hip_atomic_fetch_add(p, v, __ATOMIC_RELAXED, __HIP_MEMORY_SCOPE_AGENT); }
__device__ __forceinline__ unsigned xb_xcc_id() { return (unsigned)__builtin_amdgcn_s_getreg((3 << 11) | 20) & 0xFu; }
#define XB_SPIN(cond, bar) do { unsigned _sp = 0; while (cond) { __builtin_amdgcn_s_sleep(1); \
    if ((++_sp & 255u) == 0u) { if (xb_ld(&(bar)[XB_TMO])) break; if (_sp > XB_SPIN_CAP) { atomicAdd(&(bar)[XB_TMO], 1u); break; } } } } while (0)

struct XcdBarrier {
    unsigned* bar; unsigned x;
    volatile LAS unsigned* st;
};
__device__ __forceinline__ XcdBarrier xcd_barrier_post(unsigned* bar, volatile LAS unsigned* st) {
    XcdBarrier b; b.bar = bar; b.x = xb_xcc_id(); b.st = st;
    if (threadIdx.x == 0) (void)xb_add(&bar[XB_XCNT(b.x)], 1u);
    return b;
}
__device__ __forceinline__ void xcd_barrier_complete(unsigned* bar, unsigned x, unsigned& nloc, unsigned& nx) {
    const unsigned G = gridDim.x * gridDim.y * gridDim.z;
    unsigned sum, cnt, mine, sp = 0u;
    for (;;) {
        sum = 0u; cnt = 0u; mine = 0u;
#pragma unroll
        for (unsigned j = 0; j < 16; ++j) { const unsigned c = xb_ld(&bar[XB_XCNT(j)]); sum += c; cnt += (c > 0u) ? 1u : 0u; mine = (j == x) ? c : mine; }
        if (sum == G) break;
        __builtin_amdgcn_s_sleep(1);
        if ((++sp & 255u) == 0u) { if (xb_ld(&bar[XB_TMO])) break; if (sp > XB_SPIN_CAP) { atomicAdd(&bar[XB_TMO], 1u); break; } }
    }
    nloc = mine > 0u ? mine : 1u; nx = cnt > 0u ? cnt : 1u;
}

__device__ __forceinline__ void xcd_barrier(const XcdBarrier& b) {
    asm volatile("s_waitcnt vmcnt(0)" ::: "memory");
    __syncthreads();
    if (threadIdx.x == 0) {
        unsigned* bar = b.bar;
        __builtin_amdgcn_s_waitcnt(0);
        unsigned nloc = b.st[0], nx = b.st[1];
        if (nloc == 0u) { xcd_barrier_complete(bar, b.x, nloc, nx); b.st[0] = nloc; b.st[1] = nx; }
        const unsigned old = xb_add(&bar[XB_XSUB(b.x)], 1u);
        const unsigned gen = old / nloc;
        if (old + 1u == (gen + 1u) * nloc) {
            __builtin_amdgcn_fence(__ATOMIC_RELEASE, "agent");
            asm volatile("s_waitcnt vmcnt(0)" ::: "memory");
            const unsigned og = xb_add(&bar[XB_TOP], 1u);
            const unsigned tg = og / nx;
            if (og + 1u == (tg + 1u) * nx) xb_add(&bar[XB_TOPGEN], 1u);
            else XB_SPIN(xb_ld(&bar[XB_TOPGEN]) == tg, bar);
            __builtin_amdgcn_fence(__ATOMIC_ACQUIRE, "agent");
            xb_add(&bar[XB_XGEN(b.x)], 1u);
            asm volatile("s_waitcnt vmcnt(0)" ::: "memory");
        } else {
            XB_SPIN(xb_ld(&bar[XB_XGEN(b.x)]) == gen, bar);
            __builtin_amdgcn_fence(__ATOMIC_ACQUIRE, "agent");
            asm volatile("s_waitcnt vmcnt(0)" ::: "memory");
        }
    }
    __syncthreads();
}

__device__ __forceinline__ void rope_table(float2* R, int widx, int NW, int tid) {
    for (int i = widx * 512 + tid; i < 4096 * 16; i += NW * 512) { const int pos = i >> 4, fi = i & 15; const float inv = powf(10000.0f, -(float)fi * (1.0f / 16.0f)); const float ang = (float)pos * inv;
        R[i] = make_float2((float)cos((double)ang), (float)sin((double)ang)); }
}
constexpr int NPHASE = 12;
__global__ void __launch_bounds__(512, 2) mega_fwd(Params p, int ph_lo, int ph_hi) {
    extern __shared__ __attribute__((aligned(16))) unsigned char lds_raw[];
    LAS unsigned char* lds = (LAS unsigned char*)lds_raw;
    cg::grid_group grid = cg::this_grid();
    const int tid = threadIdx.x, lane = tid & 63, wave = __builtin_amdgcn_readfirstlane(tid >> 6);
    const int G = gridDim.x, bx = blockIdx.x;
    const int vcu = (G % 8 == 0) ? (bx % 8) * (G / 8) + bx / 8 : bx;
    const int gw = vcu * 8 + wave, NGW = G * 8;
    const bool rebal = (G == 256);
    const bool fuse_norm = (G == 256) && (ph_hi - ph_lo == NPHASE);
    typedef const __attribute__((address_space(4))) Params* KPtr;
#define KP_LOAD() KPtr kp = (KPtr)__builtin_amdgcn_kernarg_segment_ptr(); asm volatile("" : "+s"(kp)); unsigned char* ws = kp->ws; (void)ws
#define MOD ((float*)(ws + WS_MOD))
#define ROPE ((const float2*)(ws + WS_ROPE))
#define WIN0 ((bf16*)(ws + WS_WIN0))
#define WOUT0 ((bf16*)(ws + WS_WOUT0))
#define WIN1 ((bf16*)(ws + WS_WIN1))
#define WOUT1 ((bf16*)(ws + WS_WOUT1))
#define WUQ ((bf16*)(ws + WS_WUQ))
#define WUKV ((bf16*)(ws + WS_WUKV))
#define H ((bf16*)(ws + WS_H))
#define P ((bf16*)(ws + WS_P))
#define QB ((bf16*)(ws + WS_QB))
#define KVB ((bf16*)(ws + WS_KVB))
#define MIX ((bf16*)(ws + WS_MIX))
#define CQN ((bf16*)(ws + WS_CQN))
#define CKVN ((bf16*)(ws + WS_CKVN))
#ifndef PH_MASK
#define PH_MASK 0xfff
#endif
#define IN(k) (((PH_MASK >> (k)) & 1) && ph_lo <= (k) && (k) < ph_hi)
    volatile LAS unsigned* xb_st = (volatile LAS unsigned*)(lds + LDS_BYTES - 64);
    if (tid < 16) xb_st[tid] = 0u;
    __syncthreads();
    XcdBarrier xbar = xcd_barrier_post((unsigned*)(p.ws + WS_CTL), xb_st);
    if (ph_hi - ph_lo > 1) grid.sync();
#define SEAM(k) do { if (IN(k) && IN((k) + 1)) xcd_barrier(xbar); } while (0)

    if (IN(0)) { KP_LOAD();
        LAS float* scr = (LAS float*)(lds + wave * 16384);
        if (rebal) {
            if (vcu < 192) {
                LAS float* red = (LAS float*)(lds + 131072);
                const int l = vcu / 96, rem = vcu % 96, kh = rem & 1, kb = kh * 512 + wave * 64, jc = (rem >> 1) * 64 + lane;
                for (int i = lane; i < 256; i += 64) { const float cv = kp->c[(i >> 6) * DM + kb + (i & 63)]; scr[i] = cv / (1.f + __expf(-cv)); }
                LDS_WAIT(); asm volatile("" ::: "memory");
                const float* w = kp->ada_w + (size_t)l * DM * 3072 + (size_t)kb * 3072 + jc;
                float a0 = 0.f, a1 = 0.f, a2 = 0.f, a3 = 0.f;
#pragma unroll 16
                for (int i = 0; i < 64; ++i) { const float wv = w[(size_t)i * 3072]; a0 += scr[i] * wv; a1 += scr[64 + i] * wv; a2 += scr[128 + i] * wv; a3 += scr[192 + i] * wv; }
                red[(wave * 4 + 0) * 64 + lane] = a0; red[(wave * 4 + 1) * 64 + lane] = a1; red[(wave * 4 + 2) * 64 + lane] = a2; red[(wave * 4 + 3) * 64 + lane] = a3;
                __syncthreads();
                if (wave < 4) { float sum = kh == 0 ? kp->ada_b[l * 3072 + jc] : 0.f;
#pragma unroll
                    for (int w8 = 0; w8 < 8; ++w8) sum += red[(w8 * 4 + wave) * 64 + lane];
                    __hip_atomic_fetch_add((float*)(ws + WS_MOD) + (size_t)l * 4 * 3072 + (size_t)wave * 3072 + jc, sum, __ATOMIC_RELAXED, __HIP_MEMORY_SCOPE_AGENT); }
            } else {
                const int w0 = (vcu - 192) * 8 + wave, nw0 = (G - 192) * 8; constexpr int I4 = 4 * 24, I5 = 2 * 16, I6 = 2 * 16;
                for (int it = w0; it < I4 + I5 + I6; it += nw0) { int r = it;
                    if (r < I4) { transpose_item(kp->b_w_uq, 256, 768, WUQ, 0, scr, r, lane); continue; } r -= I4;
                    if (r < I5) { transpose_item(kp->b_w_uk, 128, 512, WUKV, 0, scr, r, lane); continue; } r -= I5;
                    transpose_item(kp->b_w_uv, 128, 512, WUKV, 512, scr, r, lane); }
                rope_table((float2*)(ws + WS_ROPE), w0 >> 3, nw0 >> 3, tid);
                const int gt = w0 * 64 + lane, NT = nw0 * 64; v4u z = {0u, 0u, 0u, 0u};
                for (int i = gt; i < (N0 - N0_REAL) * DM / 8; i += NT) *((v4u*)(WIN0 + (size_t)N0_REAL * DM) + i) = z;
            }
        } else {
        for (int it = vcu; it < 96; it += G) {
            LAS float* red = (LAS float*)(lds + 131072);
            const int kb = wave * 128;
            for (int i = lane; i < 512; i += 64) { const float cv = kp->c[(i >> 7) * DM + kb + (i & 127)]; scr[i] = cv / (1.f + __expf(-cv)); }
            LDS_WAIT(); asm volatile("" ::: "memory");
            const int l = it / 48, jc = (it % 48) * 64 + lane; const float* w = kp->ada_w + (size_t)l * DM * 3072 + (size_t)kb * 3072 + jc;
            float a0 = 0.f, a1 = 0.f, a2 = 0.f, a3 = 0.f;
#pragma unroll 16
            for (int i = 0; i < 128; ++i) { const float wv = w[(size_t)i * 3072]; a0 += scr[i] * wv; a1 += scr[128 + i] * wv; a2 += scr[256 + i] * wv; a3 += scr[384 + i] * wv; }
            red[(wave * 4 + 0) * 64 + lane] = a0; red[(wave * 4 + 1) * 64 + lane] = a1; red[(wave * 4 + 2) * 64 + lane] = a2; red[(wave * 4 + 3) * 64 + lane] = a3;
            __syncthreads();
            if (wave < 4) { float sum = kp->ada_b[l * 3072 + jc];
#pragma unroll
                for (int w8 = 0; w8 < 8; ++w8) sum += red[(w8 * 4 + wave) * 64 + lane];
                ((float*)(ws + WS_MOD))[(size_t)l * 4 * 3072 + (size_t)wave * 3072 + jc] = sum; }
            __syncthreads();
        }
        { const bool split = G > 96; const int w0 = split ? (vcu - 96) * 8 + wave : gw, nw0 = split ? (G - 96) * 8 : NGW;
          if (!split || vcu >= 96) {
              constexpr int I0 = 16 * (N0_REAL / 32), I4 = 4 * 24, I5 = 2 * 16, I6 = 2 * 16;
              for (int it = w0; it < I0 + (rebal ? I4 + I5 + I6 : 0); it += nw0) { int r = it;
                  if (r < I0) { transpose_item(kp->even_w_in, DM, N0_REAL, WIN0, 0, scr, r, lane); continue; } r -= I0;
                  if (r < I4) { transpose_item(kp->b_w_uq, 256, 768, WUQ, 0, scr, r, lane); continue; } r -= I4;
                  if (r < I5) { transpose_item(kp->b_w_uk, 128, 512, WUKV, 0, scr, r, lane); continue; } r -= I5;
                  transpose_item(kp->b_w_uv, 128, 512, WUKV, 512, scr, r, lane); }
              if (rebal) rope_table((float2*)(ws + WS_ROPE), w0 >> 3, nw0 >> 3, tid);
              const int gt = w0 * 64 + lane, NT = nw0 * 64; v4u z = {0u, 0u, 0u, 0u};
              for (int i = gt; i < (N0 - N0_REAL) * DM / 8; i += NT) *((v4u*)(WIN0 + (size_t)N0_REAL * DM) + i) = z;
          } }
        }
    }
    SEAM(0);
    if (IN(1)) { KP_LOAD();
        if (rebal) { LAS float* scr = (LAS float*)(lds + wave * 16384);
            for (int it = gw; it < 16 * (N0_REAL / 32); it += NGW) transpose_item(kp->even_w_in, DM, N0_REAL, WIN0, 0, scr, it, lane); }
        adaln_rows(kp->x, kp->norm_w, MOD, H, gw, NGW, lane); }
    SEAM(1);
    if (IN(2)) { KP_LOAD();
        if (rebal) {
            pg8::Gemm g{H, WIN0, TOK, 2048, DM, DM}; pg8::StaticOrder S; S.init(TOK, 2048, G, bx);
            pg8::EpiStore E{P, N0, 0, 1.f};
            pg8::gemm_phase<pg8::EpiStore, pg8::StaticOrder, PG8_ALIGN, PG8_SP2>(lds, g, S, E);
        } else {
        pg8::Gemm g{H, WIN0, TOK, N0, DM, DM}; pg8::StaticOrder S; S.init(TOK, N0, G, bx);
        pg8::EpiStore E{P, N0, 0, 1.f};
        pg8::gemm_phase<pg8::EpiStore, pg8::StaticOrder, PG8_ALIGN, PG8_SP2>(lds, g, S, E);
        { constexpr int NU = (TOK / 256) * (N0 / 256); const int rem = NU % G; const bool idle = rem == 0 || bx >= rem; const int widx = rem == 0 ? bx : bx - rem, NW = rem == 0 ? G : G - rem;
          if (idle) { LAS float* scr = (LAS float*)(lds + wave * 16384);
              constexpr int I1 = 16 * 32, I2 = 16 * (N1 / 32), I4 = 4 * 24, I5 = 2 * 16, I6 = 2 * 16;
              for (int it = widx * 8 + wave; it < I1 + I2 + I4 + I5 + I6; it += NW * 8) { int r = it;
                  if (r < I4) { transpose_item(kp->b_w_uq, 256, 768, WUQ, 0, scr, r, lane); continue; } r -= I4;
                  if (r < I5) { transpose_item(kp->b_w_uk, 128, 512, WUKV, 0, scr, r, lane); continue; } r -= I5;
                  if (r < I6) { transpose_item(kp->b_w_uv, 128, 512, WUKV, 512, scr, r, lane); continue; } r -= I6;
                  if (r < I1) { transpose_item(kp->even_w_out, DM, DM, WOUT0, 0, scr, r, lane); continue; } r -= I1;
                  transpose_item(kp->odd_w_in, DM, N1, WIN1, 0, scr, r, lane); }
              rope_table((float2*)(ws + WS_ROPE), widx, NW, tid); } }
        }
    }
    SEAM(2);
    if (IN(3)) { KP_LOAD(); post_rows(kp->a_q_norm, kp->a_k_norm, kp->b_q_lora_norm, kp->b_kv_lora_norm, P, CQN, CKVN, ROPE, gw, NGW, lane); }
    SEAM(3);
    if (IN(4)) { KP_LOAD();
        if (rebal) {
            if (bx < 192) {
                { int kk = 256; asm volatile("" : "+s"(kk)); pg8::Gemm g{CQN, WUQ, TOK, 768, kk, kk}; pg8::StaticOrder S; S.init(TOK, 768, 192, bx);
                  pg8::EpiStore E{QB, 768, 768, C2B};
                  pg8::gemm_phase<pg8::EpiStore, pg8::StaticOrder, PG8_ALIGN, PG8_SP2>(lds, g, S, E); }
                { int kk = 128; asm volatile("" : "+s"(kk)); pg8::Gemm g{CKVN, WUKV, TOK, 1024, kk, kk}; pg8::StaticOrder S; S.init(TOK, 1024, 192, bx);
                  pg8::EpiStore E{KVB, 1024, 0, 1.f};
                  pg8::gemm_phase<pg8::EpiStore, pg8::StaticOrder, PG8_ALIGN, PG8_SP2>(lds, g, S, E); }
            } else {
                pg8::Gemm g{H, WIN0 + (size_t)2048 * DM, TOK, 256, DM, DM}; pg8::StaticOrder S; S.init(TOK, 256, 64, bx - 192);
                pg8::EpiStore E{P + 2048, N0, 0, 1.f};
                pg8::gemm_phase<pg8::EpiStore, pg8::StaticOrder, PG8_ALIGN, PG8_SP2>(lds, g, S, E);
            }
            { LAS float* scr = (LAS float*)(lds + wave * 16384); constexpr int I1 = 16 * 32, I2 = 16 * (N1 / 32);
              for (int it = gw; it < I1 + I2; it += NGW) { if (it < I1) transpose_item(kp->even_w_out, DM, DM, WOUT0, 0, scr, it, lane); else transpose_item(kp->odd_w_in, DM, N1, WIN1, 0, scr, it - I1, lane); } }
        } else {
        { int kk = 256; asm volatile("" : "+s"(kk)); pg8::Gemm g{CQN, WUQ, TOK, 768, kk, kk}; pg8::StaticOrder S; S.init(TOK, 768, G, bx);
          pg8::EpiStore E{QB, 768, 768, C2B};
          pg8::gemm_phase<pg8::EpiStore, pg8::StaticOrder, PG8_ALIGN, PG8_SP2>(lds, g, S, E); }
        { int kk = 128; asm volatile("" : "+s"(kk)); pg8::Gemm g{CKVN, WUKV, TOK, 1024, kk, kk}; pg8::StaticOrder S; S.init(TOK, 1024, G, bx);
          pg8::EpiStore E{KVB, 1024, 0, 1.f};
          pg8::gemm_phase<pg8::EpiStore, pg8::StaticOrder, PG8_ALIGN, PG8_SP2>(lds, g, S, E); }
        }
    }
    SEAM(4);
    if (IN(5)) { KP_LOAD();
        for (int L0 = vcu; L0 < 512; L0 += G) {
            const int L = (G == 256 && (vcu & 1)) ? (L0 ^ 256) : L0;
            if (L < 256) {
                const int bh = L >> 3, b = bh >> 3, h = bh & 7, qb = L & 7; const size_t r0 = (size_t)b * SEQ;
                att2::attn_unit<96, 0>(lds, QB + r0 * 768 + h * 96, KVB + r0 * 1024 + h * 64, P + r0 * N0 + C_KR, KVB + r0 * 1024 + 512 + h * 64, P + r0 * N0 + C_GB + h * 64, MIX + r0 * DM + 512 + h * 64,
                                       768, 1024, N0, 1024, N0, DM, qb * 512, 0, SEQ / 64, 0.f, 0.f, ROPE);
            } else {
                const int Lr = L - 256, grp = Lr >> 5, b = grp >> 1, kvh = grp & 1, h = kvh * 4 + ((Lr & 31) >> 3), qb = Lr & 7; const size_t r0 = (size_t)b * SEQ;
                const bf16* Pb = P + r0 * N0;
                att2::attn_unit<64, 0>(lds, Pb + C_QA + h * 64, Pb + C_KA + kvh * 64, Pb + C_KA + kvh * 64, Pb + C_VA + kvh * 64, Pb + C_GA + h * 64, MIX + r0 * DM + h * 64,
                                       N0, N0, N0, N0, N0, DM, qb * 512, 0, SEQ / 64, 0.f, 0.f, ROPE, kp->a_q_norm);
            }
        }
    }
    SEAM(5);
    if (IN(6)) { KP_LOAD();
        pg8::Gemm g{MIX, WOUT0, TOK, DM, DM, DM}; pg8::StaticOrder S; S.init(TOK, DM, G, bx);
        if (fuse_norm) {
            pg8::PanelRms st{(float*)(ws + WS_XB6), (unsigned*)(ws + WS_CNT6), EPS};
            pg8::EpiResNorm<false> E{kp->x, kp->out, MOD + 2048, DM, st, kp->norm_w + DM, MOD + 4 * 3072, H, KVB};
            pg8::gemm_phase<pg8::EpiResNorm<false>, pg8::StaticOrder, false, PG8_SP2>(lds, g, S, E);
        } else {
            pg8::EpiRes E{kp->x, kp->out, MOD + 2048, DM};
            pg8::gemm_phase<pg8::EpiRes, pg8::StaticOrder, PG8_ALIGN, PG8_SP2>(lds, g, S, E);
        }
    }
    SEAM(6);
    if (IN(7) && !fuse_norm) { KP_LOAD(); adaln_rows(kp->out, kp->norm_w + DM, MOD + 4 * 3072, H, gw, NGW, lane); }
    if (!fuse_norm) SEAM(7);
    if (IN(8)) { KP_LOAD();
        pg8::Gemm g{H, WIN1, TOK, N1, DM, DM}; pg8::StaticOrder S; S.init(TOK, N1, G, bx);
        pg8::EpiStore E{P, N1, 1024, C2A};
        pg8::gemm_phase<pg8::EpiStore, pg8::StaticOrder, PG8_ALIGN, PG8_SP2>(lds, g, S, E);
        { constexpr int NU = (TOK / 256) * (N1 / 256); const int rem = NU % G; const bool idle = rem == 0 || bx >= rem; const int widx = rem == 0 ? bx : bx - rem, NW = rem == 0 ? G : G - rem;
          if (idle) { LAS float* scr = (LAS float*)(lds + wave * 16384);
              for (int it = widx * 8 + wave; it < 16 * 32; it += NW * 8) transpose_item(kp->odd_w_out, DM, DM, WOUT1, 0, scr, it, lane); } }
    }
    SEAM(8);
    if (IN(9)) { KP_LOAD();
        for (int L = vcu; L < 512; L += G) {
            const int grp = L >> 5, b = grp >> 2, kvh = grp & 3, h = kvh * 4 + 2 * ((L & 31) >> 4), u = L & 15; const size_t r0 = (size_t)b * SEQ;
            const bf16* Pb = P + r0 * N1;
            att6::attn_unit_win(lds, Pb + C_QC + h * 64, Pb + C_KC + kvh * 64, Pb + C_VC + kvh * 64, Pb + C_GC + h * 64, MIX + r0 * DM + h * 64,
                                N1, DM, u * 256, u * 4 - 2, SEQ / 64, exp2f(-0.5f * (float)(h + 1)) * LOG2E, kp->c_sink[h] * LOG2E, exp2f(-0.5f * (float)(h + 2)) * LOG2E, kp->c_sink[h + 1] * LOG2E);
        }
    }
    SEAM(9);
    if (IN(10)) { KP_LOAD();
        pg8::Gemm g{MIX, WOUT1, TOK, DM, DM, DM}; pg8::StaticOrder S; S.init(TOK, DM, G, bx);
        if (fuse_norm) {
            pg8::PanelRms st{(float*)(ws + WS_XB10), (unsigned*)(ws + WS_CNT10), EPS};
            pg8::EpiResNorm<true> E{kp->out, kp->out, MOD + 4 * 3072 + 2048, DM, st, kp->final_norm, nullptr, nullptr, KVB};
            pg8::gemm_phase<pg8::EpiResNorm<true>, pg8::StaticOrder, false, PG8_SP2>(lds, g, S, E);
        } else {
            pg8::EpiRes E{kp->out, kp->out, MOD + 4 * 3072 + 2048, DM};
            pg8::gemm_phase<pg8::EpiRes, pg8::StaticOrder, PG8_ALIGN, PG8_SP2>(lds, g, S, E);
        }
    }
    if (!fuse_norm) SEAM(10);
    if (IN(11) && !fuse_norm) { KP_LOAD();
        float* outp = kp->out; const float* fnw = kp->final_norm; constexpr int NR = 4;
        for (int mb = gw; mb < TOK; mb += NR * NGW) {
            f32x4 v[NR][4]; float ss[NR]; int mr[NR];
#pragma unroll
            for (int r = 0; r < NR; ++r) { const int m = mb + r * NGW; mr[r] = m < TOK ? m : mb; const f32x4* xr = (const f32x4*)(outp + (size_t)mr[r] * DM) + lane;
#pragma unroll
                for (int j = 0; j < 4; ++j) v[r][j] = xr[64 * j]; }
#pragma unroll
            for (int r = 0; r < NR; ++r) { float s_ = 0.f;
#pragma unroll
                for (int j = 0; j < 4; ++j) s_ += (v[r][j].x * v[r][j].x + v[r][j].y * v[r][j].y) + (v[r][j].z * v[r][j].z + v[r][j].w * v[r][j].w);
                ss[r] = 1.f / sqrtf(wave_sum(s_) * (1.f / DM) + EPS); }
#pragma unroll
            for (int j = 0; j < 4; ++j) { const f32x4 w = *(const f32x4*)(fnw + 4 * (lane + 64 * j));
#pragma unroll
                for (int r = 0; r < NR; ++r) { if (r > 0 && mb + r * NGW >= TOK) continue; ((f32x4*)(outp + (size_t)mr[r] * DM) + lane)[64 * j] = v[r][j] * ss[r] * w; } }
        }
    }
#undef IN
#undef SEAM
#undef MOD
#undef ROPE
#undef WIN0
#undef WOUT0
#undef WIN1
#undef WOUT1
#undef WUQ
#undef WUKV
#undef H
#undef P
#undef QB
#undef KVB
#undef MIX
#undef CQN
#undef CKVN
}

#ifndef MK_MULTI
#define MK_MULTI 0
#endif
extern "C" void kernel_launch(void* const* d_in, const int* in_sizes, int n_in, void* d_out, int out_size, void* d_ws, size_t ws_size, hipStream_t stream) {
    static int grid = 0;
    if (grid == 0) {
        if (n_in != 18 || out_size != TOK * DM || ws_size < WS_END) { fprintf(stderr, "kernel_launch: unexpected problem (n_in %d out %d ws %zu)\n", n_in, out_size, ws_size); grid = -1; return; }
        int dev = 0, cus = 0, per_cu = 0;
        hipGetDevice(&dev); hipDeviceGetAttribute(&cus, hipDeviceAttributeMultiprocessorCount, dev);
        if (hipFuncSetAttribute((const void*)mega_fwd, hipFuncAttributeMaxDynamicSharedMemorySize, LDS_BYTES) != hipSuccess) { fprintf(stderr, "kernel_launch: hipFuncSetAttribute failed\n"); grid = -1; return; }
        if (hipOccupancyMaxActiveBlocksPerMultiprocessor(&per_cu, (const void*)mega_fwd, 512, LDS_BYTES) != hipSuccess || per_cu < 1) { fprintf(stderr, "kernel_launch: occupancy query says %d\n", per_cu); per_cu = 1; }
        (void)hipGetLastError();
        grid = cus * (per_cu > 1 ? 1 : per_cu);
    }
    if (grid < 0) return;
    if (hipMemsetAsync((char*)d_ws + WS_CTL, 0, WS_MOD + 2 * 4 * 3072 * sizeof(float), stream) != hipSuccess) {   fprintf(stderr, "kernel_launch: memset failed\n"); return; }
    Params p{};
    const float** pf = (const float**)&p;
    for (int i = 0; i < 18; ++i) pf[i] = (const float*)d_in[i];
    p.out = (float*)d_out; p.ws = (unsigned char*)d_ws;
#if MK_MULTI
    for (int k = 0; k < NPHASE; ++k) hipLaunchKernelGGL(mega_fwd, dim3(grid), dim3(512), LDS_BYTES, stream, p, k, k + 1);
#else
    int lo = 0, hi = NPHASE;
    void* args[] = {&p, &lo, &hi};
    hipError_t e = hipLaunchCooperativeKernel((void*)mega_fwd, dim3(grid), dim3(512), args, LDS_BYTES, stream);
    if (e != hipSuccess) fprintf(stderr, "cooperative launch failed: %s (grid %d)\n", hipGetErrorString(e), grid);
#endif
}
```

```cpp
#include <hip/hip_runtime.h>
#include <hip/hip_cooperative_groups.h>
#include <cstdio>
#include <cstdint>
#include <cmath>
namespace cg = cooperative_groups;
namespace pg8 {
#define PG8_LAS __attribute__((address_space(3)))
typedef unsigned short bf16_t;
typedef short bf16x8 __attribute__((ext_vector_type(8)));
typedef float f32x4 __attribute__((ext_vector_type(4)));
typedef unsigned u32x4 __attribute__((ext_vector_type(4)));
constexpr int BM = 256, BK = 64, HALF = 128, HTB = HALF * BK * 2  , STAGE_BYTES = 8 * HTB, NXCD = 8, WGM = 8;

__host__ __device__ __forceinline__ int lds_byte(int r, int c) { const int st = (r >> 4) * 2 + (c >> 5), rr = r & 15, cc = c & 31, ob = rr * 64 + cc * 2; return st * 1024 + (ob ^ (((ob >> 9) & 1) << 5)); }
__host__ __device__ __forceinline__ void stage_rc(int b, int& R, int& C) { const int st = b / 1024, sb = b % 1024, swz = sb ^ (((sb >> 9) & 1) << 5); R = (st >> 1) * 16 + swz / 64; C = (st & 1) * 32 + (swz % 64) / 2; }
__host__ __device__ __forceinline__ int perm32(int rho) { const int n = rho >> 4, i = rho & 15; return 8 * (i >> 2) + 4 * n + (i & 3); }

struct Unit { int pm, pn; };
struct Gemm { const bf16_t* A; const bf16_t* Bt; int M, N, K, lda; };

struct StaticOrder {
    int nM, nN, nwg, G, c;
    __host__ __device__ void init(int M, int N, int G_, int c_) { nM = M / BM; nN = N / BM; nwg = nM * nN; G = G_; c = c_; }
    __host__ __device__ bool next(int i, Unit& u) const {
        const long L = (long)i * G + c; if (L >= nwg) return false;
        int wgid = (int)L; { const int q = nwg / NXCD, r = nwg % NXCD, xcd = wgid % NXCD, off = wgid / NXCD; wgid = (xcd < r ? xcd * (q + 1) : r * (q + 1) + (xcd - r) * q) + off; }
        const int nig = WGM * nN, gid = wgid / nig, fm = gid * WGM, gsz = (nM - fm) < WGM ? (nM - fm) : WGM;
        u.pm = fm + ((wgid % nig) % gsz); u.pn = (wgid % nig) / gsz; return true;
    }
    __device__ __forceinline__ void a_ready(const Unit&) const {}
    __device__ __forceinline__ void done(const Unit&) const {}
};

__device__ __forceinline__ unsigned cvt_pk_bf16(float lo, float hi) { unsigned r; asm volatile("v_cvt_pk_bf16_f32 %0, %1, %2" : "=v"(r) : "v"(lo), "v"(hi)); return r; }
typedef float f32x2 __attribute__((ext_vector_type(2)));
template <class Epi, class Sched, bool ALIGN_EPI = false, bool SP2 = false>
__device__ __forceinline__ void gemm_phase(PG8_LAS unsigned char* lds, const Gemm g, const Sched& S, const Epi& E) {
    const int tid = threadIdx.x, wid = __builtin_amdgcn_readfirstlane(tid >> 6), lane = tid & 63, wr = wid >> 2, wc = wid & 3, fr = lane & 15, fq = lane >> 4;
    const int K = g.K, nt = K / BK;
    unsigned voffA[2], voffB[2];
#pragma unroll
    for (int i = 0; i < 2; ++i) { int R, C; stage_rc(tid * 16 + i * 8192, R, C); const int Rb = Epi::PERM ? ((R & ~31) + perm32(R & 31)) : R;
        voffA[i] = (unsigned)(R * g.lda + C) * 2u; voffB[i] = (unsigned)(Rb * K + C) * 2u; }
    const size_t kstep = (size_t)(BK * 2);
    const size_t hstepA = (size_t)HALF * g.lda * 2, hstepB = (size_t)HALF * K * 2;
    const size_t tstepA = 2 * hstepA, tstepB = 2 * hstepB;
    const unsigned ldsw = (unsigned)wid * 1024u;
    const int aoff = lds_byte(wr * 64 + fr, fq * 8), boff = lds_byte(wc * 32 + fr, fq * 8);
#define PG8_SA(b, h) (((b) * 2 + (h)) * HTB)
#define PG8_SB(b, h) ((4 + (b) * 2 + (h)) * HTB)
#define PG8_STAGE(bufoff, gbase, voff) do { _Pragma("unroll") for (int _i = 0; _i < 2; ++_i) \
        __builtin_amdgcn_global_load_lds((const unsigned*)((const char*)(gbase) + (voff)[_i]), (PG8_LAS unsigned*)(lds + (bufoff) + ldsw + _i * 8192), 16, 0, 0); } while (0)
#define PG8_LDA(dst, b, h) do { _Pragma("unroll") for (int m = 0; m < 4; ++m) _Pragma("unroll") for (int k = 0; k < 2; ++k) dst[m][k] = *(const PG8_LAS bf16x8*)(lds + PG8_SA(b, h) + aoff + m * 2048 + k * 1024); } while (0)
#define PG8_LDB(dst, b, h) do { _Pragma("unroll") for (int n = 0; n < 2; ++n) _Pragma("unroll") for (int k = 0; k < 2; ++k) dst[n][k] = *(const PG8_LAS bf16x8*)(lds + PG8_SB(b, h) + boff + n * 2048 + k * 1024); } while (0)
#define PG8_MMA(ai, bj, At, Bt) do { __builtin_amdgcn_s_setprio(1); _Pragma("unroll") for (int m = 0; m < 4; ++m) _Pragma("unroll") for (int n = 0; n < 2; ++n) _Pragma("unroll") for (int k = 0; k < 2; ++k) \
        acc[ai][bj][m][n] = __builtin_amdgcn_mfma_f32_16x16x32_bf16(Bt[n][k], At[m][k], acc[ai][bj][m][n], 0, 0, 0); __builtin_amdgcn_s_setprio(0); } while (0)
#define PG8_WAIT_V(n) asm volatile("s_waitcnt vmcnt(" #n ")" ::: "memory")
#define PG8_WAIT_L(n) asm volatile("s_waitcnt lgkmcnt(" #n ")" ::: "memory")
#define PG8_BAR __builtin_amdgcn_s_barrier()
#define PG8_SCHED __builtin_amdgcn_sched_barrier(0)
    Unit cur, nxt; int ui = 0;
    if (!S.next(0, cur)) return;
    f32x4 acc[2][2][4][2];
#pragma unroll
    for (int a = 0; a < 2; ++a)
#pragma unroll
        for (int b = 0; b < 2; ++b)
#pragma unroll
            for (int m = 0; m < 4; ++m)
#pragma unroll
                for (int n = 0; n < 2; ++n) acc[a][b][m][n] = (f32x4){0.f, 0.f, 0.f, 0.f};
    bf16x8 At[4][2], B0[2][2], B1[2][2];
    const char* cA = (const char*)g.A + (size_t)cur.pm * tstepA; const char* cB = (const char*)g.Bt + (size_t)cur.pn * tstepB;
    S.a_ready(cur);
    if constexpr (SP2) {
        PG8_STAGE(PG8_SB(0, 0), cB, voffB); PG8_STAGE(PG8_SB(0, 1), cB + hstepB, voffB); PG8_STAGE(PG8_SA(0, 0), cA, voffA); PG8_STAGE(PG8_SA(0, 1), cA + hstepA, voffA);
        if (wr == 1) PG8_BAR;
        PG8_WAIT_V(2); PG8_BAR;
        PG8_STAGE(PG8_SB(1, 0), cB + kstep, voffB); PG8_STAGE(PG8_SA(1, 0), cA + kstep, voffA); PG8_STAGE(PG8_SB(1, 1), cB + hstepB + kstep, voffB);
        PG8_WAIT_V(6); PG8_BAR;
    } else {
        PG8_STAGE(PG8_SB(0, 0), cB, voffB); PG8_STAGE(PG8_SA(0, 0), cA, voffA); PG8_STAGE(PG8_SB(0, 1), cB + hstepB, voffB); PG8_STAGE(PG8_SA(0, 1), cA + hstepA, voffA);
        if (wr == 1) PG8_BAR;
        PG8_WAIT_V(4); PG8_BAR;
        PG8_STAGE(PG8_SB(1, 0), cB + kstep, voffB); PG8_STAGE(PG8_SA(1, 0), cA + kstep, voffA); PG8_STAGE(PG8_SB(1, 1), cB + hstepB + kstep, voffB);
        PG8_WAIT_V(6); PG8_BAR;
    }
    for (;;) {
        const bool has_next = S.next(ui + 1, nxt);
        const char* nA = has_next ? (const char*)g.A + (size_t)nxt.pm * tstepA : cA; const char* nB = has_next ? (const char*)g.Bt + (size_t)nxt.pn * tstepB : cB;
        for (int t = 0; t < nt; t += 2) {
            const bool last = (t == nt - 2);
            const char* a1 = cA + (size_t)(t + 1) * kstep;
            const char* a2 = last ? nA : cA + (size_t)(t + 2) * kstep; const char* b2 = last ? nB : cB + (size_t)(t + 2) * kstep;
            const char* a3 = a2 + kstep; const char* b3 = b2 + kstep;
            if (last && has_next) S.a_ready(nxt);
            if constexpr (SP2) {
            PG8_LDB(B0, 0, 0); PG8_LDB(B1, 0, 1); PG8_SCHED; PG8_LDA(At, 0, 0); PG8_STAGE(PG8_SA(1, 1), a1 + hstepA, voffA);
            PG8_WAIT_V(8); PG8_WAIT_L(0); PG8_BAR; PG8_MMA(0, 0, At, B0); PG8_MMA(0, 1, At, B1); PG8_BAR; PG8_SCHED;
            PG8_LDA(At, 0, 1); PG8_STAGE(PG8_SB(0, 0), b2, voffB); PG8_STAGE(PG8_SB(0, 1), b2 + hstepB, voffB); PG8_STAGE(PG8_SA(0, 0), a2, voffA);
            PG8_WAIT_V(8); PG8_WAIT_L(0); PG8_BAR; PG8_MMA(1, 0, At, B0); PG8_MMA(1, 1, At, B1); PG8_BAR; PG8_SCHED;
            PG8_LDB(B0, 1, 0); PG8_LDB(B1, 1, 1); PG8_SCHED; PG8_LDA(At, 1, 0); PG8_STAGE(PG8_SA(0, 1), a2 + hstepA, voffA);
            PG8_WAIT_V(8); PG8_WAIT_L(0); PG8_BAR; PG8_MMA(0, 0, At, B0); PG8_MMA(0, 1, At, B1); PG8_BAR; PG8_SCHED;
            PG8_LDA(At, 1, 1); PG8_STAGE(PG8_SB(1, 0), b3, voffB); PG8_STAGE(PG8_SB(1, 1), b3 + hstepB, voffB); PG8_STAGE(PG8_SA(1, 0), a3, voffA);
            PG8_WAIT_V(8); PG8_WAIT_L(0); PG8_BAR; PG8_MMA(1, 0, At, B0); PG8_MMA(1, 1, At, B1); PG8_BAR; PG8_SCHED;
            } else {
            PG8_LDB(B0, 0, 0); PG8_SCHED; PG8_LDA(At, 0, 0); PG8_STAGE(PG8_SA(1, 1), a1 + hstepA, voffA);
            PG8_WAIT_L(8); PG8_BAR; PG8_WAIT_L(0); PG8_MMA(0, 0, At, B0); PG8_BAR; PG8_SCHED;
            PG8_LDB(B1, 0, 1); PG8_STAGE(PG8_SB(0, 0), b2, voffB);
            PG8_BAR; PG8_WAIT_L(0); PG8_MMA(0, 1, At, B1); PG8_BAR;
            PG8_LDA(At, 0, 1); PG8_STAGE(PG8_SA(0, 0), a2, voffA);
            PG8_BAR; PG8_WAIT_L(0); PG8_MMA(1, 0, At, B0); PG8_BAR; PG8_SCHED;
            PG8_STAGE(PG8_SB(0, 1), b2 + hstepB, voffB);
            PG8_WAIT_V(6); PG8_BAR; PG8_MMA(1, 1, At, B1); PG8_BAR;
            PG8_LDB(B0, 1, 0); PG8_SCHED; PG8_LDA(At, 1, 0); PG8_STAGE(PG8_SA(0, 1), a2 + hstepA, voffA);
            PG8_WAIT_L(8); PG8_BAR; PG8_WAIT_L(0); PG8_MMA(0, 0, At, B0); PG8_BAR; PG8_SCHED;
            PG8_LDB(B1, 1, 1); PG8_STAGE(PG8_SB(1, 0), b3, voffB);
            PG8_BAR; PG8_WAIT_L(0); PG8_MMA(0, 1, At, B1); PG8_BAR;
            PG8_LDA(At, 1, 1); PG8_STAGE(PG8_SA(1, 0), a3, voffA);
            PG8_BAR; PG8_WAIT_L(0); PG8_MMA(1, 0, At, B0); PG8_BAR; PG8_SCHED;
            PG8_STAGE(PG8_SB(1, 1), b3 + hstepB, voffB);
            PG8_WAIT_V(6); PG8_BAR; PG8_MMA(1, 1, At, B1); PG8_BAR;
            }
        }
        if constexpr (ALIGN_EPI) { if (wr == 0) PG8_BAR; }
        if constexpr (!Epi::AFTER_DRAIN) { E(acc, cur, wr, wc, fr, fq); S.done(cur); }
        if (!has_next) break;
#pragma unroll
        for (int a = 0; a < 2; ++a)
#pragma unroll
            for (int b = 0; b < 2; ++b)
#pragma unroll
                for (int m = 0; m < 4; ++m)
#pragma unroll
                    for (int n = 0; n < 2; ++n) acc[a][b][m][n] = (f32x4){0.f, 0.f, 0.f, 0.f};
        cur = nxt; cA = nA; cB = nB; ++ui;
        if constexpr (ALIGN_EPI) { if (wr == 1) PG8_BAR; }
    }
    PG8_WAIT_V(0);
    if constexpr (!ALIGN_EPI) { if (wr == 0) PG8_BAR; }
    PG8_BAR;
    if constexpr (Epi::AFTER_DRAIN) { E.fused(acc, cur, wr, wc, fr, fq, lds, wid, lane); S.done(cur); }
#undef PG8_SA
#undef PG8_SB
#undef PG8_STAGE
#undef PG8_LDA
#undef PG8_LDB
#undef PG8_MMA
#undef PG8_WAIT_V
#undef PG8_WAIT_L
#undef PG8_BAR
#undef PG8_SCHED
}
}
#define PG8_SP2 true
#define PG8_ALIGN true
namespace pg8 {
typedef unsigned u32x2 __attribute__((ext_vector_type(2)));
struct EpiStore {
    static constexpr bool PERM = true, AFTER_DRAIN = false;
    bf16_t* O; int ldc; int scale_cols; float scale0;
    __device__ __forceinline__ void operator()(const f32x4 (&acc)[2][2][4][2], const Unit& u, int wr, int wc, int fr, int fq) const {
        const int row0 = u.pm * BM + wr * 64 + fr; const int col0 = u.pn * BM + wc * 32 + 8 * fq;
        const float sc = (u.pn * BM < scale_cols) ? scale0 : 1.f;
#pragma unroll
        for (int ai = 0; ai < 2; ++ai)
#pragma unroll
            for (int m = 0; m < 4; ++m) { bf16_t* rowp = O + (size_t)(row0 + ai * HALF + m * 16) * ldc + col0;
#pragma unroll
                for (int bj = 0; bj < 2; ++bj) { f32x4 v0 = acc[ai][bj][m][0] * sc, v1 = acc[ai][bj][m][1] * sc;
                    u32x4 w; w.x = cvt_pk_bf16(v0[0], v0[1]); w.y = cvt_pk_bf16(v0[2], v0[3]); w.z = cvt_pk_bf16(v1[0], v1[1]); w.w = cvt_pk_bf16(v1[2], v1[3]);
                    *(u32x4*)(rowp + bj * HALF) = w; } }
    }
};
struct EpiQb {
    static constexpr bool PERM = false, AFTER_DRAIN = false;
    bf16_t* O; int ldc; const float2* rope; float sc;
    __device__ __forceinline__ void operator()(const f32x4 (&acc)[2][2][4][2], const Unit& u, int wr, int wc, int fr, int fq) const {
        const int row0 = u.pm * BM + wr * 64 + fr;
#pragma unroll
        for (int bj = 0; bj < 2; ++bj) { const int colg = u.pn * BM + bj * HALF + wc * 32; const bool is_rope = ((colg >> 5) % 3) == 2;
#pragma unroll
            for (int ai = 0; ai < 2; ++ai)
#pragma unroll
                for (int m = 0; m < 4; ++m) { const int row = row0 + ai * HALF + m * 16; f32x4 v0 = acc[ai][bj][m][0], v1 = acc[ai][bj][m][1];
                    if (is_rope) { const float2* rp = rope + (size_t)(row & 4095) * 16 + 4 * fq;
#pragma unroll
                        for (int e = 0; e < 4; ++e) { const float2 cs = rp[e]; const float x1 = v0[e], x2 = v1[e]; v0[e] = x1 * cs.x - x2 * cs.y; v1[e] = x1 * cs.y + x2 * cs.x; } }
                    v0 = v0 * sc; v1 = v1 * sc; bf16_t* rowp = O + (size_t)row * ldc + colg + 4 * fq;
                    u32x2 a, b; a.x = cvt_pk_bf16(v0[0], v0[1]); a.y = cvt_pk_bf16(v0[2], v0[3]); b.x = cvt_pk_bf16(v1[0], v1[1]); b.y = cvt_pk_bf16(v1[2], v1[3]);
                    *(u32x2*)rowp = a; *(u32x2*)(rowp + 16) = b; asm volatile("" ::: "memory"); } }
    }
};
struct EpiRes {
    static constexpr bool PERM = true, AFTER_DRAIN = false;
    const float* base; float* out; const float* gate; int ldc;
    __device__ __forceinline__ void operator()(const f32x4 (&acc)[2][2][4][2], const Unit& u, int wr, int wc, int fr, int fq) const {
        const int row0 = u.pm * BM + wr * 64 + fr; const int b = (u.pm * BM) >> 12; const int col0 = u.pn * BM + wc * 32 + 8 * fq;
#pragma unroll
        for (int bj = 0; bj < 2; ++bj) { const int col = col0 + bj * HALF; const f32x4 g0 = *(const f32x4*)(gate + (size_t)b * 3072 + col), g1 = *(const f32x4*)(gate + (size_t)b * 3072 + col + 4);
#pragma unroll
            for (int ai = 0; ai < 2; ++ai)
#pragma unroll
                for (int m = 0; m < 4; ++m) { const size_t off = (size_t)(row0 + ai * HALF + m * 16) * ldc + col;
                    const f32x4 b0 = *(const f32x4*)(base + off), b1 = *(const f32x4*)(base + off + 4);
                    *(f32x4*)(out + off) = b0 + g0 * acc[ai][bj][m][0]; *(f32x4*)(out + off + 4) = b1 + g1 * acc[ai][bj][m][1]; } }
    }
};
struct PanelRms {
    float* xbuf; unsigned* cnt; float eps;
    __device__ __forceinline__ void run(const f32x4 (&v)[2][2][4][2], const Unit& u, int wr, int wc, int fr, int fq, PG8_LAS unsigned char* lds, int wid, int lane) const {
        PG8_LAS float* Pp = (PG8_LAS float*)lds;
        PG8_LAS float* S = (PG8_LAS float*)(lds + 4096);
#pragma unroll
        for (int ai = 0; ai < 2; ++ai)
#pragma unroll
            for (int m = 0; m < 4; ++m) { float q = 0.f;
#pragma unroll
                for (int bj = 0; bj < 2; ++bj)
#pragma unroll
                    for (int n = 0; n < 2; ++n) { const f32x4 x = v[ai][bj][m][n]; q += (x[0] * x[0] + x[1] * x[1]) + (x[2] * x[2] + x[3] * x[3]); }
                q += __shfl_xor(q, 16); q += __shfl_xor(q, 32);
                if (fq == 0) Pp[(ai * HALF + wr * 64 + m * 16 + fr) * 4 + wc] = q; }
        asm volatile("s_waitcnt lgkmcnt(0)" ::: "memory"); __builtin_amdgcn_s_barrier(); asm volatile("" ::: "memory");
        const int row = wid * 32 + (lane & 31);
        if (lane < 32) { const f32x4 a = *(const PG8_LAS f32x4*)(Pp + row * 4);
            __hip_atomic_store(xbuf + ((size_t)(u.pm * BM + row) * 4 + u.pn), (a[0] + a[1]) + (a[2] + a[3]), __ATOMIC_RELAXED, __HIP_MEMORY_SCOPE_AGENT); }
        asm volatile("s_waitcnt vmcnt(0)" ::: "memory");
        if (lane == 0) __hip_atomic_fetch_add(cnt + 64 * u.pm, 1u, __ATOMIC_RELAXED, __HIP_MEMORY_SCOPE_AGENT);
        if (wid == 0) {
            for (unsigned sp = 0; sp < (1u << 22); ++sp) {
                if ((unsigned)__builtin_amdgcn_readfirstlane(__hip_atomic_load(cnt + 64 * u.pm, __ATOMIC_RELAXED, __HIP_MEMORY_SCOPE_AGENT)) >= 32u) break;
                __builtin_amdgcn_s_sleep(2); }
            __builtin_amdgcn_fence(__ATOMIC_ACQUIRE, "agent");
        }
        asm volatile("s_waitcnt vmcnt(0) lgkmcnt(0)" ::: "memory"); __builtin_amdgcn_s_barrier(); asm volatile("" ::: "memory");
        if (lane < 32) { const float* slot = xbuf + (size_t)(u.pm * BM + row) * 4; float q = 0.f;
#pragma unroll
            for (int t = 0; t < 4; ++t) q += __hip_atomic_load(slot + t, __ATOMIC_RELAXED, __HIP_MEMORY_SCOPE_AGENT);
            S[row] = 1.0f / sqrtf(q * (1.0f / 1024.0f) + eps); }
        asm volatile("s_waitcnt vmcnt(0) lgkmcnt(0)" ::: "memory"); __builtin_amdgcn_s_barrier(); asm volatile("" ::: "memory");
    }
};
template <bool FINAL> struct EpiResNorm {
    static constexpr bool PERM = true, AFTER_DRAIN = true;
    const float* base; float* out; const float* gate; int ldc; PanelRms st; const float* nw; const float* modn; bf16_t* Hn; bf16_t* x1b;
    __device__ __forceinline__ void operator()(const f32x4 (&)[2][2][4][2], const Unit&, int, int, int, int) const {}
    __device__ __forceinline__ void fused(f32x4 (&acc)[2][2][4][2], const Unit& u, int wr, int wc, int fr, int fq, PG8_LAS unsigned char* lds, int wid, int lane) const {
        const int row0 = u.pm * BM + wr * 64 + fr; const int b = (u.pm * BM) >> 12; const int col0 = u.pn * BM + wc * 32 + 8 * fq;
#pragma unroll
        for (int bj = 0; bj < 2; ++bj) { const int col = col0 + bj * HALF; const f32x4 g0 = *(const f32x4*)(gate + (size_t)b * 3072 + col), g1 = *(const f32x4*)(gate + (size_t)b * 3072 + col + 4);
#pragma unroll
            for (int ai = 0; ai < 2; ++ai)
#pragma unroll
                for (int m = 0; m < 4; ++m) { const size_t off = (size_t)(row0 + ai * HALF + m * 16) * ldc + col;
                    f32x4 b0, b1;
                    if (FINAL) { const u32x4 rw = *(const u32x4*)(x1b + off);
                        b0 = (f32x4){__uint_as_float(rw.x << 16), __uint_as_float(rw.x & 0xffff0000u), __uint_as_float(rw.y << 16), __uint_as_float(rw.y & 0xffff0000u)};
                        b1 = (f32x4){__uint_as_float(rw.z << 16), __uint_as_float(rw.z & 0xffff0000u), __uint_as_float(rw.w << 16), __uint_as_float(rw.w & 0xffff0000u)}; }
                    else { b0 = *(const f32x4*)(base + off); b1 = *(const f32x4*)(base + off + 4); }
                    acc[ai][bj][m][0] = b0 + g0 * acc[ai][bj][m][0]; acc[ai][bj][m][1] = b1 + g1 * acc[ai][bj][m][1];
                    asm volatile("" : "+v"(acc[ai][bj][m][0]), "+v"(acc[ai][bj][m][1]));
                    if (m == 3) asm volatile("" ::: "memory"); } }
        f32x4 ww0[2], ww1[2], hh0[2], hh1[2];
#pragma unroll
        for (int bj = 0; bj < 2; ++bj) { const int col = col0 + bj * HALF;
            ww0[bj] = *(const f32x4*)(nw + col); ww1[bj] = *(const f32x4*)(nw + col + 4); hh0[bj] = (f32x4){0.f, 0.f, 0.f, 0.f}; hh1[bj] = hh0[bj];
            if (!FINAL) { const float* mb = modn + (size_t)b * 3072; ww0[bj] = ww0[bj] * (*(const f32x4*)(mb + 1024 + col) + 1.f); ww1[bj] = ww1[bj] * (*(const f32x4*)(mb + 1024 + col + 4) + 1.f); hh0[bj] = *(const f32x4*)(mb + col); hh1[bj] = *(const f32x4*)(mb + col + 4); } }
        st.run(acc, u, wr, wc, fr, fq, lds, wid, lane);
        const PG8_LAS float* S = (const PG8_LAS float*)(lds + 4096);
#pragma unroll
        for (int bj = 0; bj < 2; ++bj) { const int col = col0 + bj * HALF;
            const f32x4 w0 = ww0[bj], w1 = ww1[bj], h0 = hh0[bj], h1 = hh1[bj];
#pragma unroll
            for (int ai = 0; ai < 2; ++ai)
#pragma unroll
                for (int m = 0; m < 4; ++m) { const int r = ai * HALF + wr * 64 + m * 16 + fr; const float rstd = S[r]; const size_t off = (size_t)(u.pm * BM + r) * ldc + col;
                    const f32x4 x0 = acc[ai][bj][m][0], x1 = acc[ai][bj][m][1];
                    if (FINAL) { *(f32x4*)(out + off) = x0 * rstd * w0; *(f32x4*)(out + off + 4) = x1 * rstd * w1; }
                    else { { u32x4 xw; xw.x = cvt_pk_bf16(x0[0], x0[1]); xw.y = cvt_pk_bf16(x0[2], x0[3]); xw.z = cvt_pk_bf16(x1[0], x1[1]); xw.w = cvt_pk_bf16(x1[2], x1[3]); *(u32x4*)(x1b + off) = xw; }
                        const f32x4 y0 = x0 * rstd * w0 + h0, y1 = x1 * rstd * w1 + h1;
                        u32x4 w; w.x = cvt_pk_bf16(y0[0], y0[1]); w.y = cvt_pk_bf16(y0[2], y0[3]); w.z = cvt_pk_bf16(y1[0], y1[1]); w.w = cvt_pk_bf16(y1[2], y1[3]);
                        *(u32x4*)(Hn + off) = w; }
                    if (m & 1) asm volatile("" ::: "memory"); } }
    }
};
}
namespace att {
#define LAS3 __attribute__((address_space(3)))
typedef unsigned short bf16_t;
typedef short bf16x8 __attribute__((ext_vector_type(8)));
typedef short s16x4 __attribute__((ext_vector_type(4)));
typedef float f32x16 __attribute__((ext_vector_type(16)));
typedef float f32x4 __attribute__((ext_vector_type(4)));
typedef unsigned u32x4 __attribute__((ext_vector_type(4)));
typedef float f32x2_t __attribute__((ext_vector_type(2)));
typedef __bf16 bf16x2_t __attribute__((ext_vector_type(2)));
constexpr int KSLOT = 14336, VSLOT = 8192;
constexpr int L_K = 0, L_V = 2 * KSLOT, L_WS = L_V + 2 * VSLOT, L_OST = L_WS + 8 * 256, L_BYTES = L_OST + 8 * 4096;
__device__ __forceinline__ int crow(int r, int hi) { return (r & 3) + 8 * (r >> 2) + 4 * hi; }
__device__ __forceinline__ unsigned cvtpk(float lo, float hi) { f32x2_t v = {lo, hi}; bf16x2_t b = __builtin_convertvector(v, bf16x2_t); return __builtin_bit_cast(unsigned, b); }
__device__ __forceinline__ float bflo(unsigned u) { return __uint_as_float(u << 16); }
__device__ __forceinline__ float bfhi(unsigned u) { return __uint_as_float(u & 0xffff0000u); }
__device__ __forceinline__ s16x4 vtr(const LAS3 char* p) { return __builtin_bit_cast(s16x4, __builtin_amdgcn_ds_read_tr16_b64_v4i16((LAS3 s16x4*)p)); }
__device__ __forceinline__ float swapmax(float m) { auto rr = __builtin_amdgcn_permlane32_swap(__float_as_uint(m), __float_as_uint(m), false, false); return fmaxf(__uint_as_float(rr[0]), __uint_as_float(rr[1])); }
__device__ __forceinline__ float swapsum(float m) { auto rr = __builtin_amdgcn_permlane32_swap(__float_as_uint(m), __float_as_uint(m), false, false); return __uint_as_float(rr[0]) + __uint_as_float(rr[1]); }
__device__ __forceinline__ float silu_f(float g) { return g * __builtin_amdgcn_rcpf(1.f + __builtin_amdgcn_exp2f(-1.4426950408889634f * g)); }

__device__ __forceinline__ void glds16s(const void* sbase, unsigned voff, unsigned lds_dst) { unsigned keep;
    asm volatile("s_mov_b32 %0, m0\n\ts_mov_b32 m0, %3\n\ts_nop 0\n\tglobal_load_lds_dwordx4 %1, %2\n\ts_mov_b32 m0, %0" : "=&s"(keep) : "v"(voff), "s"(sbase), "s"(lds_dst) : "memory"); }
}
namespace att2 {
using namespace att;
constexpr int M_K = 0, M_V = 2 * KSLOT, M_WS = M_V + 2 * VSLOT, M_OST = M_WS + 8 * 512, M_BYTES = M_OST + 8 * 8192;
__device__ __forceinline__ void softmax_half(f32x16& p0, f32x16& p1, float& m, float& l, f32x16& o0, f32x16& o1, LAS3 float* wsf, u32x4 (&pw)[4], int hi, int r32) {
    float ra = fmaxf(fmaxf(p0[0], p0[1]), p1[0]), rb = fmaxf(fmaxf(p0[2], p0[3]), p1[1]); ra = fmaxf(fmaxf(ra, p1[2]), p1[3]);
#pragma unroll
    for (int r = 4; r < 16; r += 4) { ra = fmaxf(fmaxf(ra, p0[r]), p0[r + 1]); rb = fmaxf(fmaxf(rb, p0[r + 2]), p0[r + 3]); ra = fmaxf(fmaxf(ra, p1[r]), p1[r + 1]); rb = fmaxf(fmaxf(rb, p1[r + 2]), p1[r + 3]); }
    const float rm = swapmax(fmaxf(ra, rb));
    const float mn = fmaxf(m, rm);
    if (__any(rm > m + 8.0f)) {
        const float alpha = __builtin_amdgcn_exp2f(m - mn);
        l *= alpha; m = mn;
        if (hi == 0) wsf[r32] = alpha;
        asm volatile("s_waitcnt lgkmcnt(0)" ::: "memory");
#pragma unroll
        for (int r4 = 0; r4 < 4; ++r4) { const f32x4 al = *(const LAS3 f32x4*)(wsf + 8 * r4 + 4 * hi);
#pragma unroll
            for (int e = 0; e < 4; ++e) { o0[4 * r4 + e] *= al[e]; o1[4 * r4 + e] *= al[e]; } }
        asm volatile("s_waitcnt lgkmcnt(0)" ::: "memory");
    }
    float s0 = 0.f, s1 = 0.f;
#pragma unroll
    for (int r = 0; r < 16; ++r) { p0[r] = __builtin_amdgcn_exp2f(p0[r] - m); p1[r] = __builtin_amdgcn_exp2f(p1[r] - m); s0 += p0[r]; s1 += p1[r]; }
    l += s0 + s1;
#pragma unroll
    for (int e = 0; e < 4; ++e) { pw[0][e] = cvtpk(p0[2 * e], p0[2 * e + 1]); pw[1][e] = cvtpk(p0[8 + 2 * e], p0[8 + 2 * e + 1]);
                                  pw[2][e] = cvtpk(p1[2 * e], p1[2 * e + 1]); pw[3][e] = cvtpk(p1[8 + 2 * e], p1[8 + 2 * e + 1]); }
}
__device__ __forceinline__ void rope_q(bf16x8& q1, bf16x8& q2, const float2* rp) {
    const u32x4 x1 = __builtin_bit_cast(u32x4, q1), x2 = __builtin_bit_cast(u32x4, q2); u32x4 y1, y2;
#pragma unroll
    for (int e = 0; e < 4; ++e) { const float2 c0 = rp[2 * e], c1 = rp[2 * e + 1];
        const float a0 = bflo(x1[e]), a1 = bfhi(x1[e]), b0 = bflo(x2[e]), b1 = bfhi(x2[e]);
        y1[e] = cvtpk(a0 * c0.x - b0 * c0.y, a1 * c1.x - b1 * c1.y); y2[e] = cvtpk(a0 * c0.y + b0 * c0.x, a1 * c1.y + b1 * c1.x); }
    q1 = __builtin_bit_cast(bf16x8, y1); q2 = __builtin_bit_cast(bf16x8, y2);
}
__device__ __forceinline__ void stage_half(const f32x16& o0, const f32x16& o1, float l, LAS3 float* wsf, LAS3 bf16_t* stg, int hi, int r32) {
    l = swapsum(l);
    if (hi == 0) wsf[32 + r32] = l;
    asm volatile("s_waitcnt lgkmcnt(0)" ::: "memory");
#pragma unroll
    for (int r4 = 0; r4 < 4; ++r4) { const f32x4 lv = *(const LAS3 f32x4*)(wsf + 32 + 8 * r4 + 4 * hi);
#pragma unroll
        for (int e = 0; e < 4; ++e) { const int r = 4 * r4 + e; const float rl = __builtin_amdgcn_rcpf(lv[e]); const int orow = crow(r, hi);
            stg[orow * 64 + r32] = (bf16_t)(cvtpk(o0[r] * rl, 0.f) & 0xffffu); stg[orow * 64 + 32 + r32] = (bf16_t)(cvtpk(o1[r] * rl, 0.f) & 0xffffu); } }
}
__device__ __forceinline__ void qproc_a(bf16x8 (&q)[4], const float* g, const float2* rope, int pos_seq, int hi, float osc) {
    float x[4][8]; float ss = 0.f;
#pragma unroll
    for (int d0 = 0; d0 < 4; ++d0) { const u32x4 u = __builtin_bit_cast(u32x4, q[d0]);
#pragma unroll
        for (int e = 0; e < 4; ++e) { x[d0][2 * e] = bflo(u[e]); x[d0][2 * e + 1] = bfhi(u[e]); ss += x[d0][2 * e] * x[d0][2 * e] + x[d0][2 * e + 1] * x[d0][2 * e + 1]; } }
    ss = swapsum(ss);
    const float rstd = 1.0f / sqrtf(ss * (1.0f / 64.0f) + 1e-6f);
    const float2* rr = rope + (size_t)(pos_seq >> 6) * 16 + 8 * hi; const float2* rc = rope + (size_t)(pos_seq & 63) * 16 + 8 * hi;
#pragma unroll
    for (int d0 = 0; d0 < 4; ++d0)
#pragma unroll
        for (int e = 0; e < 8; ++e) x[d0][e] *= rstd * g[16 * d0 + 8 * hi + e];
    u32x4 y[4];
#pragma unroll
    for (int e = 0; e < 4; ++e) { float a[2], b[2], c[2], d[2];
#pragma unroll
        for (int k = 0; k < 2; ++k) { const float2 cr = rr[2 * e + k], cc = rc[2 * e + k]; const float x1 = x[0][2 * e + k], x2 = x[1][2 * e + k], z1 = x[2][2 * e + k], z2 = x[3][2 * e + k];
            a[k] = (x1 * cr.x - x2 * cr.y) * osc; b[k] = (x1 * cr.y + x2 * cr.x) * osc; c[k] = (z1 * cc.x - z2 * cc.y) * osc; d[k] = (z1 * cc.y + z2 * cc.x) * osc; }
        y[0][e] = cvtpk(a[0], a[1]); y[1][e] = cvtpk(b[0], b[1]); y[2][e] = cvtpk(c[0], c[1]); y[3][e] = cvtpk(d[0], d[1]); }
#pragma unroll
    for (int d0 = 0; d0 < 4; ++d0) q[d0] = __builtin_bit_cast(bf16x8, y[d0]);
}
__device__ __forceinline__ void softmax_rel(f32x16& p0, f32x16& p1, float& m, float& l, f32x16& o0, f32x16& o1, LAS3 float* wsf, u32x4 (&pw)[4], bool first, int hi, int r32) {
    float ra = fmaxf(fmaxf(p0[0], p0[1]), p1[0]), rb = fmaxf(fmaxf(p0[2], p0[3]), p1[1]); ra = fmaxf(fmaxf(ra, p1[2]), p1[3]);
#pragma unroll
    for (int r = 4; r < 16; r += 4) { ra = fmaxf(fmaxf(ra, p0[r]), p0[r + 1]); rb = fmaxf(fmaxf(rb, p0[r + 2]), p0[r + 3]); ra = fmaxf(fmaxf(ra, p1[r]), p1[r + 1]); rb = fmaxf(fmaxf(rb, p1[r + 2]), p1[r + 3]); }
    const float rm = swapmax(fmaxf(ra, rb));
    if (first || __any(rm > 8.0f)) {
        const float mt = m + (first ? rm : fmaxf(rm, 0.f));
        const unsigned mb = cvtpk(mt, 0.f) & 0xffffu; const float mn = __uint_as_float(mb << 16);
        const float delta = mn - m;
#pragma unroll
        for (int r = 0; r < 16; ++r) { p0[r] -= delta; p1[r] -= delta; }
        const float alpha = first ? 1.f : __builtin_amdgcn_exp2f(-delta);
        l *= alpha; m = mn;
        if (hi == 0) wsf[r32] = alpha;
        asm volatile("s_waitcnt lgkmcnt(0)" ::: "memory");
#pragma unroll
        for (int r4 = 0; r4 < 4; ++r4) { const f32x4 al = *(const LAS3 f32x4*)(wsf + 8 * r4 + 4 * hi);
#pragma unroll
            for (int e = 0; e < 4; ++e) { o0[4 * r4 + e] *= al[e]; o1[4 * r4 + e] *= al[e]; } }
        asm volatile("s_waitcnt lgkmcnt(0)" ::: "memory");
    }
    float s0 = 0.f, s1 = 0.f;
#pragma unroll
    for (int r = 0; r < 16; ++r) { p0[r] = __builtin_amdgcn_exp2f(p0[r]); p1[r] = __builtin_amdgcn_exp2f(p1[r]); s0 += p0[r]; s1 += p1[r]; }
    l += s0 + s1;
#pragma unroll
    for (int e = 0; e < 4; ++e) { pw[0][e] = cvtpk(p0[2 * e], p0[2 * e + 1]); pw[1][e] = cvtpk(p0[8 + 2 * e], p0[8 + 2 * e + 1]);
                                  pw[2][e] = cvtpk(p1[2 * e], p1[2 * e + 1]); pw[3][e] = cvtpk(p1[8 + 2 * e], p1[8 + 2 * e + 1]); }
}
template <int DQK, int MODE>
__device__ __forceinline__ void attn_unit(LAS3 unsigned char* lds, const bf16_t* aQ, const bf16_t* aK, const bf16_t* aK2, const bf16_t* aV, const bf16_t* aG, bf16_t* aO,
                                          const int a_qp, const int a_kp, const int a_k2p, const int a_vp, const int a_gp, const int a_op, const int a_q0, const int a_t_lo, const int a_t_hi,
                                          const float a_slope2, const float a_sink2, const float2* aRope, const float* aQn = nullptr) {
    constexpr int ND = DQK / 16;
    const int tid = threadIdx.x, lane = tid & 63, r32 = lane & 31, hi = lane >> 5; const int wid = __builtin_amdgcn_readfirstlane(tid >> 6);
    const int qw = a_q0 + wid * 64;
    bf16x8 qA[ND], qB[ND];
    { const bf16_t* Qw = aQ + (size_t)(qw + r32) * a_qp + hi * 8;
#pragma unroll
      for (int d0 = 0; d0 < ND; ++d0) { qA[d0] = *(const bf16x8*)(Qw + d0 * 16); qB[d0] = *(const bf16x8*)(Qw + (size_t)32 * a_qp + d0 * 16); } }
    if (DQK == 96) { rope_q(qA[ND - 2], qA[ND - 1], aRope + (size_t)(qw + r32) * 16 + 8 * hi); rope_q(qB[ND - 2], qB[ND - 1], aRope + (size_t)(qw + 32 + r32) * 16 + 8 * hi); }
    if constexpr (DQK == 64) { if (aQn) {
        qproc_a(qA, aQn, aRope, qw + r32, hi, 0.125f * 1.4426950408889634f);
#pragma unroll
        for (int d0 = 0; d0 < 4; ++d0) asm volatile("" : "+v"(qA[d0]));
        asm volatile("" ::: "memory");
        qproc_a(qB, aQn, aRope, qw + 32 + r32, hi, 0.125f * 1.4426950408889634f);
#pragma unroll
        for (int d0 = 0; d0 < 4; ++d0) asm volatile("" : "+v"(qB[d0]));
        asm volatile("" ::: "memory"); } }
    const unsigned koffg = (unsigned)(lane * a_kp + wid * 8) * 2u, k2offg = (unsigned)(lane * a_k2p + (wid & 3) * 8) * 2u, voffg = (unsigned)((16 * (wid & 3) + (lane >> 2)) * a_vp + (wid >> 2) * 32 + (lane & 3) * 8) * 2u;
    const unsigned lds0 = (unsigned)(uintptr_t)lds;
    const unsigned kdst = (unsigned)__builtin_amdgcn_readfirstlane(lds0 + M_K + wid * 1024), vdst = (unsigned)__builtin_amdgcn_readfirstlane(lds0 + M_V + wid * 1024);
    LAS3 float* wsfA = (LAS3 float*)(lds + M_WS + wid * 512); LAS3 float* wsfB = wsfA + 64;
#define AT_DMA(t, buf) do { glds16s(aK + (size_t)(t) * 64 * a_kp, koffg, kdst + (buf) * KSLOT); \
        if (DQK == 96 && wid < 4) glds16s(aK2 + (size_t)(t) * 64 * a_k2p, k2offg, kdst + (buf) * KSLOT + 8192); \
        glds16s(aV + (size_t)(t) * 64 * a_vp, voffg, vdst + (buf) * VSLOT); } while (0)
    float mA = (MODE == 1) ? a_sink2 : 0.f, mB = mA;
    float lA = (MODE == 1 && hi == 0) ? 1.f : 0.f, lB = lA;
    f32x16 oA0, oA1, oB0, oB1;
#pragma unroll
    for (int r = 0; r < 16; ++r) { oA0[r] = 0.f; oA1[r] = 0.f; oB0[r] = 0.f; oB1[r] = 0.f; }
    if (MODE == 0) {
        if (tid < 256) { const int bufi = tid >> 7, ch = (tid >> 6) & 1, row = tid & 63; const u32x4 one = {0x00003F80u, 0u, 0u, 0u}, zero = {0u, 0u, 0u, 0u};
            *(LAS3 u32x4*)(lds + M_K + bufi * KSLOT + (2 * ND + ch) * 1024 + row * 16) = ch ? zero : one; } }
    AT_DMA(a_t_lo, 0);
#pragma unroll
    for (int d0 = 0; d0 < ND; ++d0) asm volatile("" : "+v"(qA[d0]), "+v"(qB[d0]));
    asm volatile("s_waitcnt vmcnt(0)" ::: "memory"); __syncthreads();
    const int koff = hi * 1024 + r32 * 16;
    const int voff = ((lane >> 4) & 1) * 32 + (lane & 3) * 8 + (4 * hi + ((lane & 15) >> 2)) * 64;
    for (int t = a_t_lo; t < a_t_hi; ++t) {
        const int cur = (t - a_t_lo) & 1;
        if (t + 1 < a_t_hi) AT_DMA(t + 1, cur ^ 1);
        bool active = true;
        if (MODE == 1) { const int k0 = t * 64; active = (k0 + 63 >= qw - 128) && (k0 <= qw + 63 + 128); }
        if (active) {
            f32x16 pA0, pA1, pB0, pB1;
#pragma unroll
            for (int r = 0; r < 16; ++r) { pA0[r] = 0.f; pA1[r] = 0.f; pB0[r] = 0.f; pB1[r] = 0.f; }
            const LAS3 char* kb = (const LAS3 char*)(lds + M_K + cur * KSLOT + koff);
#pragma unroll
            for (int d0 = 0; d0 < ND; ++d0) {
                const bf16x8 b0 = *(const LAS3 bf16x8*)(kb + d0 * 2048), b1 = *(const LAS3 bf16x8*)(kb + d0 * 2048 + 512);
                pA0 = __builtin_amdgcn_mfma_f32_32x32x16_bf16(b0, qA[d0], pA0, 0, 0, 0);
                pA1 = __builtin_amdgcn_mfma_f32_32x32x16_bf16(b1, qA[d0], pA1, 0, 0, 0);
                pB0 = __builtin_amdgcn_mfma_f32_32x32x16_bf16(b0, qB[d0], pB0, 0, 0, 0);
                pB1 = __builtin_amdgcn_mfma_f32_32x32x16_bf16(b1, qB[d0], pB1, 0, 0, 0);
            }
            if (MODE == 0) {
                const bf16x8 b0 = *(const LAS3 bf16x8*)(kb + ND * 2048), b1 = *(const LAS3 bf16x8*)(kb + ND * 2048 + 512);
                const u32x4 qxA = {hi == 0 ? (__float_as_uint(-mA) >> 16) : 0u, 0u, 0u, 0u}, qxB = {hi == 0 ? (__float_as_uint(-mB) >> 16) : 0u, 0u, 0u, 0u};
                const bf16x8 fa = __builtin_bit_cast(bf16x8, qxA), fb = __builtin_bit_cast(bf16x8, qxB);
                pA0 = __builtin_amdgcn_mfma_f32_32x32x16_bf16(b0, fa, pA0, 0, 0, 0); pA1 = __builtin_amdgcn_mfma_f32_32x32x16_bf16(b1, fa, pA1, 0, 0, 0);
                pB0 = __builtin_amdgcn_mfma_f32_32x32x16_bf16(b0, fb, pB0, 0, 0, 0); pB1 = __builtin_amdgcn_mfma_f32_32x32x16_bf16(b1, fb, pB1, 0, 0, 0);
            }
            if (MODE == 1) { const int rel0 = t * 64 + 4 * hi - (qw + r32);
#pragma unroll
                for (int r = 0; r < 16; ++r) { const int d = rel0 + (r & 3) + 8 * (r >> 2);
                    const int a0 = d < 0 ? -d : d, a1 = (d + 32) < 0 ? -(d + 32) : (d + 32), a2 = (d - 32) < 0 ? -(d - 32) : (d - 32);
                    pA0[r] = (a0 <= 128) ? pA0[r] - a_slope2 * (float)a0 : -INFINITY; pA1[r] = (a1 <= 128) ? pA1[r] - a_slope2 * (float)a1 : -INFINITY;
                    pB0[r] = (a2 <= 128) ? pB0[r] - a_slope2 * (float)a2 : -INFINITY; pB1[r] = (a0 <= 128) ? pB1[r] - a_slope2 * (float)a0 : -INFINITY; } }
            u32x4 pwA[4], pwB[4];
            if (MODE == 0) { softmax_rel(pA0, pA1, mA, lA, oA0, oA1, wsfA, pwA, t == a_t_lo, hi, r32); softmax_rel(pB0, pB1, mB, lB, oB0, oB1, wsfB, pwB, t == a_t_lo, hi, r32); }
            else { softmax_half(pA0, pA1, mA, lA, oA0, oA1, wsfA, pwA, hi, r32); softmax_half(pB0, pB1, mB, lB, oB0, oB1, wsfB, pwB, hi, r32); }
            const LAS3 char* vb = (const LAS3 char*)(lds + M_V + cur * VSLOT + voff);
#pragma unroll
            for (int ks = 0; ks < 4; ++ks) {
                const s16x4 a0 = vtr(vb + ks * 1024), a1 = vtr(vb + ks * 1024 + 512), c0 = vtr(vb + 4096 + ks * 1024), c1 = vtr(vb + 4096 + ks * 1024 + 512);
                const bf16x8 v0 = {a0[0], a0[1], a0[2], a0[3], a1[0], a1[1], a1[2], a1[3]}, v1 = {c0[0], c0[1], c0[2], c0[3], c1[0], c1[1], c1[2], c1[3]};
                const bf16x8 pa = __builtin_bit_cast(bf16x8, pwA[ks]), pb = __builtin_bit_cast(bf16x8, pwB[ks]);
                oA0 = __builtin_amdgcn_mfma_f32_32x32x16_bf16(pa, v0, oA0, 0, 0, 0);
                oA1 = __builtin_amdgcn_mfma_f32_32x32x16_bf16(pa, v1, oA1, 0, 0, 0);
                oB0 = __builtin_amdgcn_mfma_f32_32x32x16_bf16(pb, v0, oB0, 0, 0, 0);
                oB1 = __builtin_amdgcn_mfma_f32_32x32x16_bf16(pb, v1, oB1, 0, 0, 0);
            }
        }
        asm volatile("s_waitcnt vmcnt(0)" ::: "memory"); __syncthreads();
    }
    LAS3 bf16_t* stg = (LAS3 bf16_t*)(lds + M_OST + wid * 8192);
    stage_half(oA0, oA1, lA, wsfA, stg, hi, r32);
    stage_half(oB0, oB1, lB, wsfB, stg + 32 * 64, hi, r32);
    asm volatile("s_waitcnt lgkmcnt(0)" ::: "memory");
#pragma unroll
    for (int i = 0; i < 8; ++i) { const int row = i * 8 + (lane >> 3), ch = lane & 7;
        const u32x4 ov = *(const LAS3 u32x4*)(stg + row * 64 + ch * 8);
        const u32x4 gv = *(const u32x4*)(aG + (size_t)(qw + row) * a_gp + ch * 8);
        u32x4 w;
#pragma unroll
        for (int e = 0; e < 4; ++e) w[e] = cvtpk(bflo(ov[e]) * silu_f(bflo(gv[e])), bfhi(ov[e]) * silu_f(bfhi(gv[e])));
        *(u32x4*)(aO + (size_t)(qw + row) * a_op + ch * 8) = w; }
    asm volatile("s_waitcnt lgkmcnt(0)" ::: "memory");
#undef AT_DMA
}
}
namespace att6 {
using namespace att;
constexpr int TSLOT = 16384;
constexpr int X_R = 0, X_WS = 5 * TSLOT, X_OST = X_WS + 8 * 512, X_BYTES = X_OST + 8 * 4096;
__device__ __forceinline__ void attn_unit_win(LAS3 unsigned char* lds, const bf16_t* aQ, const bf16_t* aK, const bf16_t* aV, const bf16_t* aG, bf16_t* aO,
                                              const int pitch, const int a_op, const int a_q0, const int tile0  , const int ntiles_seq,
                                              const float slopeA, const float sinkA, const float slopeB, const float sinkB) {
    const int tid = threadIdx.x, lane = tid & 63, r32 = lane & 31, hi = lane >> 5; const int wid = __builtin_amdgcn_readfirstlane(tid >> 6);
    const int qw = a_q0 + wid * 32;
    const unsigned koffg = (unsigned)(lane * pitch + wid * 8) * 2u, voffg = (unsigned)((16 * (wid & 3) + (lane >> 2)) * pitch + (wid >> 2) * 32 + (lane & 3) * 8) * 2u;
    const unsigned lds0 = (unsigned)(uintptr_t)lds;
    const unsigned kdst = (unsigned)__builtin_amdgcn_readfirstlane(lds0 + X_R + wid * 1024), vdst = kdst + 8192u;
#define A6_DMA(j) do { int tt_ = tile0 + (j); tt_ = tt_ < 0 ? 0 : (tt_ >= ntiles_seq ? ntiles_seq - 1 : tt_); const unsigned so_ = (unsigned)(((j) % 5) * TSLOT); \
        glds16s(aK + (size_t)tt_ * 64 * pitch, koffg, kdst + so_); glds16s(aV + (size_t)tt_ * 64 * pitch, voffg, vdst + so_); } while (0)
    A6_DMA(0); A6_DMA(1); A6_DMA(2); A6_DMA(3);
    bf16x8 qA[4], qB[4];
    { const bf16_t* Qw = aQ + (size_t)(qw + r32) * pitch + hi * 8;
#pragma unroll
      for (int d0 = 0; d0 < 4; ++d0) { qA[d0] = *(const bf16x8*)(Qw + d0 * 16); qB[d0] = *(const bf16x8*)(Qw + 64 + d0 * 16); } }
#pragma unroll
    for (int d0 = 0; d0 < 4; ++d0) asm volatile("" : "+v"(qA[d0]), "+v"(qB[d0]));
    LAS3 float* wsfA = (LAS3 float*)(lds + X_WS + wid * 512); LAS3 float* wsfB = wsfA + 64;
    float mA = sinkA, mB = sinkB, lA = (hi == 0) ? 1.f : 0.f, lB = lA;
    f32x16 oA0, oA1, oB0, oB1;
#pragma unroll
    for (int r = 0; r < 16; ++r) { oA0[r] = 0.f; oA1[r] = 0.f; oB0[r] = 0.f; oB1[r] = 0.f; }
    const int koff = hi * 1024 + r32 * 16;
    const int voff = 8192 + ((lane >> 4) & 1) * 32 + (lane & 3) * 8 + (4 * hi + ((lane & 15) >> 2)) * 64;
    asm volatile("s_waitcnt vmcnt(0) lgkmcnt(0)\n\ts_barrier" ::: "memory");
#pragma unroll 1
    for (int s = 0; s < 5; ++s) {
        if (s < 4) { int tt_ = tile0 + s + 4; tt_ = tt_ < 0 ? 0 : (tt_ >= ntiles_seq ? ntiles_seq - 1 : tt_); const unsigned so_ = (unsigned)((s == 0 ? 4 : s - 1) * TSLOT);
            glds16s(aK + (size_t)tt_ * 64 * pitch, koffg, kdst + so_); glds16s(aV + (size_t)tt_ * 64 * pitch, voffg, vdst + so_); }
        const int j = (wid >> 1) + s;
        const int t = tile0 + j; const int k0 = t * 64;
        const int slot = (j >= 5 ? j - 5 : j) * TSLOT;
        if (t >= 0 && t < ntiles_seq) {
            f32x16 pA0, pA1, pB0, pB1;
#pragma unroll
            for (int r = 0; r < 16; ++r) { pA0[r] = 0.f; pA1[r] = 0.f; pB0[r] = 0.f; pB1[r] = 0.f; }
            const LAS3 char* kb = (const LAS3 char*)(lds + X_R + slot + koff);
#pragma unroll
            for (int d0 = 0; d0 < 4; ++d0) {
                const bf16x8 b0 = *(const LAS3 bf16x8*)(kb + d0 * 2048), b1 = *(const LAS3 bf16x8*)(kb + d0 * 2048 + 512);
                pA0 = __builtin_amdgcn_mfma_f32_32x32x16_bf16(b0, qA[d0], pA0, 0, 0, 0); pA1 = __builtin_amdgcn_mfma_f32_32x32x16_bf16(b1, qA[d0], pA1, 0, 0, 0);
                pB0 = __builtin_amdgcn_mfma_f32_32x32x16_bf16(b0, qB[d0], pB0, 0, 0, 0); pB1 = __builtin_amdgcn_mfma_f32_32x32x16_bf16(b1, qB[d0], pB1, 0, 0, 0);
            }
            { const float fd0 = (float)(k0 + 4 * hi - (qw + r32));
#pragma unroll
              for (int r = 0; r < 16; ++r) { const float t0 = fd0 + (float)((r & 3) + 8 * (r >> 2)), t1 = t0 + 32.f;
                  pA0[r] = __builtin_fmaf(-slopeA, __builtin_fabsf(t0), pA0[r]); pA1[r] = __builtin_fmaf(-slopeA, __builtin_fabsf(t1), pA1[r]);
                  pB0[r] = __builtin_fmaf(-slopeB, __builtin_fabsf(t0), pB0[r]); pB1[r] = __builtin_fmaf(-slopeB, __builtin_fabsf(t1), pB1[r]);
                  if (s == 0 || s == 4) { const bool in0 = __builtin_fabsf(t0) <= 128.f, in1 = __builtin_fabsf(t1) <= 128.f;
                      pA0[r] = in0 ? pA0[r] : -INFINITY; pA1[r] = in1 ? pA1[r] : -INFINITY; pB0[r] = in0 ? pB0[r] : -INFINITY; pB1[r] = in1 ? pB1[r] : -INFINITY; } } }
            u32x4 pwA[4], pwB[4];
            att2::softmax_half(pA0, pA1, mA, lA, oA0, oA1, wsfA, pwA, hi, r32);
            att2::softmax_half(pB0, pB1, mB, lB, oB0, oB1, wsfB, pwB, hi, r32);
            const LAS3 char* vb = (const LAS3 char*)(lds + X_R + slot + voff);
#pragma unroll
            for (int ks = 0; ks < 4; ++ks) {
                const s16x4 a0 = vtr(vb + ks * 1024), a1 = vtr(vb + ks * 1024 + 512), c0 = vtr(vb + 4096 + ks * 1024), c1 = vtr(vb + 4096 + ks * 1024 + 512);
                const bf16x8 v0 = {a0[0], a0[1], a0[2], a0[3], a1[0], a1[1], a1[2], a1[3]}, v1 = {c0[0], c0[1], c0[2], c0[3], c1[0], c1[1], c1[2], c1[3]};
                const bf16x8 pa = __builtin_bit_cast(bf16x8, pwA[ks]), pb = __builtin_bit_cast(bf16x8, pwB[ks]);
                oA0 = __builtin_amdgcn_mfma_f32_32x32x16_bf16(pa, v0, oA0, 0, 0, 0); oA1 = __builtin_amdgcn_mfma_f32_32x32x16_bf16(pa, v1, oA1, 0, 0, 0);
                oB0 = __builtin_amdgcn_mfma_f32_32x32x16_bf16(pb, v0, oB0, 0, 0, 0); oB1 = __builtin_amdgcn_mfma_f32_32x32x16_bf16(pb, v1, oB1, 0, 0, 0);
            }
        }
        asm volatile("s_waitcnt vmcnt(0) lgkmcnt(0)\n\ts_barrier" ::: "memory");
    }
    LAS3 bf16_t* stg = (LAS3 bf16_t*)(lds + X_OST + wid * 4096);
#pragma unroll
    for (int hd = 0; hd < 2; ++hd) {
        if (hd == 0) att2::stage_half(oA0, oA1, lA, wsfA, stg, hi, r32); else att2::stage_half(oB0, oB1, lB, wsfB, stg, hi, r32);
        asm volatile("s_waitcnt lgkmcnt(0)" ::: "memory");
#pragma unroll
        for (int i = 0; i < 4; ++i) { const int row = i * 8 + (lane >> 3), ch = lane & 7;
            const u32x4 ov = *(const LAS3 u32x4*)(stg + row * 64 + ch * 8);
            const u32x4 gv = *(const u32x4*)(aG + (size_t)(qw + row) * pitch + hd * 64 + ch * 8);
            u32x4 w;
#pragma unroll
            for (int e = 0; e < 4; ++e) w[e] = cvtpk(bflo(ov[e]) * silu_f(bflo(gv[e])), bfhi(ov[e]) * silu_f(bfhi(gv[e])));
            *(u32x4*)(aO + (size_t)(qw + row) * a_op + hd * 64 + ch * 8) = w; }
        asm volatile("s_waitcnt vmcnt(0) lgkmcnt(0)" ::: "memory");
    }
#undef A6_DMA
}
}
#define GAS __attribute__((address_space(1)))
#define LAS __attribute__((address_space(3)))
typedef unsigned short bf16;
typedef unsigned v4u __attribute__((ext_vector_type(4)));
typedef unsigned v2u __attribute__((ext_vector_type(2)));
typedef float f32x4 __attribute__((ext_vector_type(4)));
constexpr int DM = 1024, NBATCH = 4, SEQ = 4096, TOK = NBATCH * SEQ;
constexpr int N0 = 2304, N0_REAL = 2208, N1 = 2560;
constexpr int C_QA = 0, C_KA = 512, C_VA = 640, C_GA = 768, C_CQ = 1280, C_CKV = 1536, C_KR = 1664, C_GB = 1696;
constexpr int C_QC = 0, C_KC = 1024, C_VC = 1280, C_GC = 1536;
constexpr float EPS = 1e-6f, LOG2E = 1.4426950408889634f;
constexpr float C2A = 0.125f * LOG2E;
constexpr float C2B = 0.10206207261596577f * LOG2E;
constexpr size_t MiB = 1u << 20;
constexpr size_t WS_CTL = 0, CTL_ZERO_BYTES = 49152;
constexpr size_t WS_CNT6 = 16384, WS_CNT10 = 32768, WS_XB6 = 256 * 1024, WS_XB10 = 512 * 1024;
constexpr size_t WS_MOD = 64 * 1024, WS_ROPE = 1 * MiB + 256 * 1024;
constexpr size_t WS_WIN0 = 2 * MiB, WS_WOUT0 = 7 * MiB, WS_WIN1 = 9 * MiB, WS_WOUT1 = 14 * MiB, WS_WUQ = 16 * MiB, WS_WUKV = 16 * MiB + 512 * 1024;
constexpr size_t WS_H = 32 * MiB, WS_P = 64 * MiB, WS_QB = 144 * MiB, WS_KVB = 168 * MiB, WS_MIX = 200 * MiB, WS_CQN = 232 * MiB, WS_CKVN = 240 * MiB, WS_END = 244 * MiB;
constexpr int LDS_BYTES = 147456;
static_assert(att2::M_BYTES <= 131072 && att6::X_BYTES <= LDS_BYTES - 64, "attention LDS");

struct Params {
    const float *x, *c, *norm_w, *ada_w, *ada_b, *even_w_in, *a_q_norm, *a_k_norm, *b_q_lora_norm, *b_kv_lora_norm, *b_w_uq, *b_w_uk, *b_w_uv, *even_w_out, *odd_w_in, *c_sink, *odd_w_out, *final_norm;
    float* out; unsigned char* ws;
};

__device__ __forceinline__ unsigned f2bf(float f) { unsigned u = __builtin_bit_cast(unsigned, f); return (u + 0x7fffu + ((u >> 16) & 1u)) >> 16; }
__device__ __forceinline__ unsigned pk2(float lo, float hi) { return f2bf(lo) | (f2bf(hi) << 16); }
__device__ __forceinline__ float bflo(unsigned u) { return __uint_as_float(u << 16); }
__device__ __forceinline__ float bfhi(unsigned u) { return __uint_as_float(u & 0xffff0000u); }
__device__ __forceinline__ float wave_sum(float v) {
#pragma unroll
    for (int o = 1; o < 64; o <<= 1) v += __shfl_xor(v, o);
    return v;
}
#define LDS_WAIT() asm volatile("s_waitcnt lgkmcnt(0)" ::: "memory")

__device__ __forceinline__ void transpose_item(const float* W, int K, int N, bf16* WT, int row_off, LAS float* scr, int item, int lane) {
    const int nblk = N / 32, kb = item / nblk, nb = item % nblk, k0 = 64 * kb, n0 = 32 * nb;
#pragma unroll 8
    for (int i = 0; i < 32; ++i) { const int kk = 2 * i + (lane >> 5); scr[kk * 33 + (lane & 31)] = W[(size_t)(k0 + kk) * N + n0 + (lane & 31)]; }
    LDS_WAIT(); asm volatile("" ::: "memory");
    const int c = lane & 7;
#pragma unroll
    for (int j = 0; j < 4; ++j) { const int n = (lane >> 3) + 8 * j; const LAS float* s = scr + (8 * c) * 33 + n;
        v4u o; o.x = pk2(s[0 * 33], s[1 * 33]); o.y = pk2(s[2 * 33], s[3 * 33]); o.z = pk2(s[4 * 33], s[5 * 33]); o.w = pk2(s[6 * 33], s[7 * 33]);
        *(v4u*)(WT + (size_t)(row_off + n0 + n) * K + k0 + 8 * c) = o; }
    LDS_WAIT(); asm volatile("" ::: "memory");
}

__device__ __forceinline__ void adaln_rows(const float* xin, const float* nw, const float* mod  , bf16* H, int gw, int NGW, int lane) {
    constexpr int NR = 4;
    for (int mb = gw; mb < TOK; mb += NR * NGW) {
        f32x4 v[NR][4]; float ss[NR]; int mr[NR];
#pragma unroll
        for (int r = 0; r < NR; ++r) { const int m = mb + r * NGW; mr[r] = m < TOK ? m : mb; const f32x4* xr = (const f32x4*)(xin + (size_t)mr[r] * DM) + lane;
#pragma unroll
            for (int j = 0; j < 4; ++j) v[r][j] = xr[64 * j]; }
#pragma unroll
        for (int r = 0; r < NR; ++r) { float s = 0.f;
#pragma unroll
            for (int j = 0; j < 4; ++j) s += (v[r][j].x * v[r][j].x + v[r][j].y * v[r][j].y) + (v[r][j].z * v[r][j].z + v[r][j].w * v[r][j].w);
            ss[r] = 1.f / sqrtf(wave_sum(s) * (1.f / DM) + EPS); }
#pragma unroll
        for (int j = 0; j < 4; ++j) { const int cidx = 4 * (lane + 64 * j); const f32x4 w = *(const f32x4*)(nw + cidx);
#pragma unroll
            for (int r = 0; r < NR; ++r) { if (r > 0 && mb + r * NGW >= TOK) continue; const float* mbp = mod + (size_t)(mr[r] >> 12) * 3072;
                const f32x4 sh = *(const f32x4*)(mbp + cidx), sc = *(const f32x4*)(mbp + 1024 + cidx); const f32x4 h = v[r][j] * ss[r] * w * (sc + 1.f) + sh;
                v2u o; o.x = pk2(h.x, h.y); o.y = pk2(h.z, h.w); *(v2u*)(H + (size_t)mr[r] * DM + cidx) = o; } }
    }
}

struct PostRaw { v4u k; v2u cq; unsigned ckv; unsigned r1, r2; float2 cs[8]; float2 ckr; };
__device__ __forceinline__ void post_load(PostRaw& R, const bf16* pr, int m, const float2* rope, int lane) {
    R.k = *(const v4u*)(pr + C_KA + 8 * (lane & 15)); R.cq = *(const v2u*)(pr + C_CQ + 4 * lane); R.ckv = *(const unsigned*)(pr + C_CKV + 2 * lane);
    R.r1 = pr[C_KR + (lane & 15)]; R.r2 = pr[C_KR + 16 + (lane & 15)];
    const int j = lane & 7, s = m & 4095; const float2* rp = rope + (size_t)((j < 4) ? (s >> 6) : (s & 63)) * 16 + 8 * (j & 1);
#pragma unroll
    for (int e = 0; e < 8; ++e) R.cs[e] = rp[e];
    R.ckr = rope[(size_t)s * 16 + (lane & 15)];
}
__device__ __forceinline__ v4u post_head(const v4u raw, const float* g8, const float2 (&rp)[8], int j, float osc) {
    float xv[8];
#pragma unroll
    for (int e = 0; e < 4; ++e) { xv[2 * e] = bflo(raw[e]); xv[2 * e + 1] = bfhi(raw[e]); }
    float ss = 0.f;
#pragma unroll
    for (int e = 0; e < 8; ++e) ss += xv[e] * xv[e];
    ss += __shfl_xor(ss, 1); ss += __shfl_xor(ss, 2); ss += __shfl_xor(ss, 4);
    const float rstd = 1.f / sqrtf(ss * (1.f / 64.f) + EPS);
    float y[8];
#pragma unroll
    for (int e = 0; e < 8; ++e) { const float xn = xv[e] * rstd * g8[e]; const float pt = __shfl_xor(xn, 2); const float2 cs = rp[e];
        y[e] = ((j & 2) == 0 ? xn * cs.x - pt * cs.y : pt * cs.y + xn * cs.x) * osc; }
    v4u o; o.x = pk2(y[0], y[1]); o.y = pk2(y[2], y[3]); o.z = pk2(y[4], y[5]); o.w = pk2(y[6], y[7]); return o;
}
__device__ __forceinline__ void post_compute(const PostRaw& R, int m, bf16* pr, const float* a_q_norm, const float* a_k_norm, const float* b_q_lora_norm, const float* b_kv_lora_norm,
                                             bf16* CQN, bf16* CKVN, const float2* rope, int lane) {
    const int j = lane & 7;
    const v4u ok = post_head(R.k, a_k_norm + 8 * j, R.cs, j, 1.f);
    if (lane < 16) *(v4u*)(pr + C_KA + 8 * lane) = ok;
    {
        const float a0 = bflo(R.cq.x), a1 = bfhi(R.cq.x), a2 = bflo(R.cq.y), a3 = bfhi(R.cq.y);
        const float rstd = 1.f / sqrtf(wave_sum((a0 * a0 + a1 * a1) + (a2 * a2 + a3 * a3)) * (1.f / 256.f) + EPS);
        const f32x4 g = *(const f32x4*)(b_q_lora_norm + 4 * lane);
        v2u o; o.x = pk2(a0 * rstd * g.x, a1 * rstd * g.y); o.y = pk2(a2 * rstd * g.z, a3 * rstd * g.w); *(v2u*)(CQN + (size_t)m * 256 + 4 * lane) = o;
    }
    {
        const float a0 = bflo(R.ckv), a1 = bfhi(R.ckv);
        const float rstd = 1.f / sqrtf(wave_sum(a0 * a0 + a1 * a1) * (1.f / 128.f) + EPS);
        const float2 g = *(const float2*)(b_kv_lora_norm + 2 * lane);
        *(unsigned*)(CKVN + (size_t)m * 128 + 2 * lane) = pk2(a0 * rstd * g.x, a1 * rstd * g.y);
    }
    if (lane < 16) {
        const float x1 = __uint_as_float(R.r1 << 16), x2 = __uint_as_float(R.r2 << 16);
        const float2 cs = R.ckr;
        pr[C_KR + lane] = (bf16)f2bf(x1 * cs.x - x2 * cs.y); pr[C_KR + 16 + lane] = (bf16)f2bf(x1 * cs.y + x2 * cs.x);
    }
}
__device__ __forceinline__ void post_rows(const float* a_q_norm, const float* a_k_norm, const float* b_q_lora_norm, const float* b_kv_lora_norm, bf16* P, bf16* CQN, bf16* CKVN, const float2* rope, int gw, int NGW, int lane) {
    constexpr int NR = 4;
    for (int mb = gw; mb < TOK; mb += NR * NGW) {
        PostRaw R[NR];
#pragma unroll
        for (int r = 0; r < NR; ++r) { const int m = mb + r * NGW; post_load(R[r], P + (size_t)(m < TOK ? m : mb) * N0, m < TOK ? m : mb, rope, lane); }
#pragma unroll
        for (int r = 0; r < NR; ++r) { const int m = mb + r * NGW; if (m < TOK) post_compute(R[r], m, P + (size_t)m * N0, a_q_norm, a_k_norm, b_q_lora_norm, b_kv_lora_norm, CQN, CKVN, rope, lane); }
    }
}
typedef unsigned v4u_xb;
#define RLX_AGENT __ATOMIC_RELAXED, __HIP_MEMORY_SCOPE_AGENT
#define XB_TMO      128
#define XB_XCNT(j)  (256  + 64 * (j))
#define XB_XSUB(j)  (1280 + 64 * (j))
#define XB_XGEN(j)  (2304 + 64 * (j))
#define XB_TOP      3328
#define XB_TOPGEN   3392
#define XCD_BAR_WORDS 3456
#define XB_SPIN_CAP (1u << 18)

__device__ __forceinline__ unsigned xb_ld(unsigned* p)              { return __hip_atomic_load(p, __ATOMIC_RELAXED, __HIP_MEMORY_SCOPE_AGENT); }
__device__ __forceinline__ unsigned xb_add(unsigned* p, unsigned v) { return __hip_atomic_fetch_add(p, v, __ATOMIC_RELAXED, __HIP_MEMORY_SCOPE_AGENT); }
__device__ __forceinline__ unsigned xb_xcc_id() { return (unsigned)__builtin_amdgcn_s_getreg((3 << 11) | 20) & 0xFu; }
#define XB_SPIN(cond, bar) do { unsigned _sp = 0; while (cond) { __builtin_amdgcn_s_sleep(1); \
    if ((++_sp & 255u) == 0u) { if (xb_ld(&(bar)[XB_TMO])) break; if (_sp > XB_SPIN_CAP) { atomicAdd(&(bar)[XB_TMO], 1u); break; } } } } while (0)

struct XcdBarrier {
    unsigned* bar; unsigned x;
    volatile LAS unsigned* st;
};
__device__ __forceinline__ XcdBarrier xcd_barrier_post(unsigned* bar, volatile LAS unsigned* st) {
    XcdBarrier b; b.bar = bar; b.x = xb_xcc_id(); b.st = st;
    if (threadIdx.x == 0) (void)xb_add(&bar[XB_XCNT(b.x)], 1u);
    return b;
}
__device__ __forceinline__ void xcd_barrier_complete(unsigned* bar, unsigned x, unsigned& nloc, unsigned& nx) {
    const unsigned G = gridDim.x * gridDim.y * gridDim.z;
    unsigned sum, cnt, mine, sp = 0u;
    for (;;) {
        sum = 0u; cnt = 0u; mine = 0u;
#pragma unroll
        for (unsigned j = 0; j < 16; ++j) { const unsigned c = xb_ld(&bar[XB_XCNT(j)]); sum += c; cnt += (c > 0u) ? 1u : 0u; mine = (j == x) ? c : mine; }
        if (sum == G) break;
        __builtin_amdgcn_s_sleep(1);
        if ((++sp & 255u) == 0u) { if (xb_ld(&bar[XB_TMO])) break; if (sp > XB_SPIN_CAP) { atomicAdd(&bar[XB_TMO], 1u); break; } }
    }
    nloc = mine > 0u ? mine : 1u; nx = cnt > 0u ? cnt : 1u;
}

__device__ __forceinline__ void xcd_barrier(const XcdBarrier& b) {
    asm volatile("s_waitcnt vmcnt(0)" ::: "memory");
    __syncthreads();
    if (threadIdx.x == 0) {
        unsigned* bar = b.bar;
        __builtin_amdgcn_s_waitcnt(0);
        unsigned nloc = b.st[0], nx = b.st[1];
        if (nloc == 0u) { xcd_barrier_complete(bar, b.x, nloc, nx); b.st[0] = nloc; b.st[1] = nx; }
        const unsigned old = xb_add(&bar[XB_XSUB(b.x)], 1u);
        const unsigned gen = old / nloc;
        if (old + 1u == (gen + 1u) * nloc) {
            __builtin_amdgcn_fence(__ATOMIC_RELEASE, "agent");
            asm volatile("s_waitcnt vmcnt(0)" ::: "memory");
            const unsigned og = xb_add(&bar[XB_TOP], 1u);
            const unsigned tg = og / nx;
            if (og + 1u == (tg + 1u) * nx) xb_add(&bar[XB_TOPGEN], 1u);
            else XB_SPIN(xb_ld(&bar[XB_TOPGEN]) == tg, bar);
            __builtin_amdgcn_fence(__ATOMIC_ACQUIRE, "agent");
            xb_add(&bar[XB_XGEN(b.x)], 1u);
            asm volatile("s_waitcnt vmcnt(0)" ::: "memory");
        } else {
            XB_SPIN(xb_ld(&bar[XB_XGEN(b.x)]) == gen, bar);
            __builtin_amdgcn_fence(__ATOMIC_ACQUIRE, "agent");
            asm volatile("s_waitcnt vmcnt(0)" ::: "memory");
        }
    }
    __syncthreads();
}

__device__ __forceinline__ void rope_table(float2* R, int widx, int NW, int tid) {
    for (int i = widx * 512 + tid; i < 4096 * 16; i += NW * 512) { const int pos = i >> 4, fi = i & 15; const float inv = powf(10000.0f, -(float)fi * (1.0f / 16.0f)); const float ang = (float)pos * inv;
        R[i] = make_float2((float)cos((double)ang), (float)sin((double)ang)); }
}
constexpr int NPHASE = 12;
__global__ void __launch_bounds__(512, 2) mega_fwd(Params p, int ph_lo, int ph_hi) {
    extern __shared__ __attribute__((aligned(16))) unsigned char lds_raw[];
    LAS unsigned char* lds = (LAS unsigned char*)lds_raw;
    cg::grid_group grid = cg::this_grid();
    const int tid = threadIdx.x, lane = tid & 63, wave = __builtin_amdgcn_readfirstlane(tid >> 6);
    const int G = gridDim.x, bx = blockIdx.x;
    const int vcu = (G % 8 == 0) ? (bx % 8) * (G / 8) + bx / 8 : bx;
    const int gw = vcu * 8 + wave, NGW = G * 8;
    const bool rebal = (G == 256);
    const bool fuse_norm = (G == 256) && (ph_hi - ph_lo == NPHASE);
    typedef const __attribute__((address_space(4))) Params* KPtr;
#define KP_LOAD() KPtr kp = (KPtr)__builtin_amdgcn_kernarg_segment_ptr(); asm volatile("" : "+s"(kp)); unsigned char* ws = kp->ws; (void)ws
#define MOD ((float*)(ws + WS_MOD))
#define ROPE ((const float2*)(ws + WS_ROPE))
#define WIN0 ((bf16*)(ws + WS_WIN0))
#define WOUT0 ((bf16*)(ws + WS_WOUT0))
#define WIN1 ((bf16*)(ws + WS_WIN1))
#define WOUT1 ((bf16*)(ws + WS_WOUT1))
#define WUQ ((bf16*)(ws + WS_WUQ))
#define WUKV ((bf16*)(ws + WS_WUKV))
#define H ((bf16*)(ws + WS_H))
#define P ((bf16*)(ws + WS_P))
#define QB ((bf16*)(ws + WS_QB))
#define KVB ((bf16*)(ws + WS_KVB))
#define MIX ((bf16*)(ws + WS_MIX))
#define CQN ((bf16*)(ws + WS_CQN))
#define CKVN ((bf16*)(ws + WS_CKVN))
#ifndef PH_MASK
#define PH_MASK 0xfff
#endif
#define IN(k) (((PH_MASK >> (k)) & 1) && ph_lo <= (k) && (k) < ph_hi)
    volatile LAS unsigned* xb_st = (volatile LAS unsigned*)(lds + LDS_BYTES - 64);
    if (tid < 16) xb_st[tid] = 0u;
    __syncthreads();
    XcdBarrier xbar = xcd_barrier_post((unsigned*)(p.ws + WS_CTL), xb_st);
    if (ph_hi - ph_lo > 1) grid.sync();
#define SEAM(k) do { if (IN(k) && IN((k) + 1)) xcd_barrier(xbar); } while (0)

    if (IN(0)) { KP_LOAD();
        LAS float* scr = (LAS float*)(lds + wave * 16384);
        if (rebal) {
            if (vcu < 192) {
                LAS float* red = (LAS float*)(lds + 131072);
                const int l = vcu / 96, rem = vcu % 96, kh = rem & 1, kb = kh * 512 + wave * 64, jc = (rem >> 1) * 64 + lane;
                for (int i = lane; i < 256; i += 64) { const float cv = kp->c[(i >> 6) * DM + kb + (i & 63)]; scr[i] = cv / (1.f + __expf(-cv)); }
                LDS_WAIT(); asm volatile("" ::: "memory");
                const float* w = kp->ada_w + (size_t)l * DM * 3072 + (size_t)kb * 3072 + jc;
                float a0 = 0.f, a1 = 0.f, a2 = 0.f, a3 = 0.f;
#pragma unroll 16
                for (int i = 0; i < 64; ++i) { const float wv = w[(size_t)i * 3072]; a0 += scr[i] * wv; a1 += scr[64 + i] * wv; a2 += scr[128 + i] * wv; a3 += scr[192 + i] * wv; }
                red[(wave * 4 + 0) * 64 + lane] = a0; red[(wave * 4 + 1) * 64 + lane] = a1; red[(wave * 4 + 2) * 64 + lane] = a2; red[(wave * 4 + 3) * 64 + lane] = a3;
                __syncthreads();
                if (wave < 4) { float sum = kh == 0 ? kp->ada_b[l * 3072 + jc] : 0.f;
#pragma unroll
                    for (int w8 = 0; w8 < 8; ++w8) sum += red[(w8 * 4 + wave) * 64 + lane];
                    __hip_atomic_fetch_add((float*)(ws + WS_MOD) + (size_t)l * 4 * 3072 + (size_t)wave * 3072 + jc, sum, __ATOMIC_RELAXED, __HIP_MEMORY_SCOPE_AGENT); }
            } else {
                const int w0 = (vcu - 192) * 8 + wave, nw0 = (G - 192) * 8; constexpr int I4 = 4 * 24, I5 = 2 * 16, I6 = 2 * 16;
                for (int it = w0; it < I4 + I5 + I6; it += nw0) { int r = it;
                    if (r < I4) { transpose_item(kp->b_w_uq, 256, 768, WUQ, 0, scr, r, lane); continue; } r -= I4;
                    if (r < I5) { transpose_item(kp->b_w_uk, 128, 512, WUKV, 0, scr, r, lane); continue; } r -= I5;
                    transpose_item(kp->b_w_uv, 128, 512, WUKV, 512, scr, r, lane); }
                rope_table((float2*)(ws + WS_ROPE), w0 >> 3, nw0 >> 3, tid);
                const int gt = w0 * 64 + lane, NT = nw0 * 64; v4u z = {0u, 0u, 0u, 0u};
                for (int i = gt; i < (N0 - N0_REAL) * DM / 8; i += NT) *((v4u*)(WIN0 + (size_t)N0_REAL * DM) + i) = z;
            }
        } else {
        for (int it = vcu; it < 96; it += G) {
            LAS float* red = (LAS float*)(lds + 131072);
            const int kb = wave * 128;
            for (int i = lane; i < 512; i += 64) { const float cv = kp->c[(i >> 7) * DM + kb + (i & 127)]; scr[i] = cv / (1.f + __expf(-cv)); }
            LDS_WAIT(); asm volatile("" ::: "memory");
            const int l = it / 48, jc = (it % 48) * 64 + lane; const float* w = kp->ada_w + (size_t)l * DM * 3072 + (size_t)kb * 3072 + jc;
            float a0 = 0.f, a1 = 0.f, a2 = 0.f, a3 = 0.f;
#pragma unroll 16
            for (int i = 0; i < 128; ++i) { const float wv = w[(size_t)i * 3072]; a0 += scr[i] * wv; a1 += scr[128 + i] * wv; a2 += scr[256 + i] * wv; a3 += scr[384 + i] * wv; }
            red[(wave * 4 + 0) * 64 + lane] = a0; red[(wave * 4 + 1) * 64 + lane] = a1; red[(wave * 4 + 2) * 64 + lane] = a2; red[(wave * 4 + 3) * 64 + lane] = a3;
            __syncthreads();
            if (wave < 4) { float sum = kp->ada_b[l * 3072 + jc];
#pragma unroll
                for (int w8 = 0; w8 < 8; ++w8) sum += red[(w8 * 4 + wave) * 64 + lane];
                ((float*)(ws + WS_MOD))[(size_t)l * 4 * 3072 + (size_t)wave * 3072 + jc] = sum; }
            __syncthreads();
        }
        { const bool split = G > 96; const int w0 = split ? (vcu - 96) * 8 + wave : gw, nw0 = split ? (G - 96) * 8 : NGW;
          if (!split || vcu >= 96) {
              constexpr int I0 = 16 * (N0_REAL / 32), I4 = 4 * 24, I5 = 2 * 16, I6 = 2 * 16;
              for (int it = w0; it < I0 + (rebal ? I4 + I5 + I6 : 0); it += nw0) { int r = it;
                  if (r < I0) { transpose_item(kp->even_w_in, DM, N0_REAL, WIN0, 0, scr, r, lane); continue; } r -= I0;
                  if (r < I4) { transpose_item(kp->b_w_uq, 256, 768, WUQ, 0, scr, r, lane); continue; } r -= I4;
                  if (r < I5) { transpose_item(kp->b_w_uk, 128, 512, WUKV, 0, scr, r, lane); continue; } r -= I5;
                  transpose_item(kp->b_w_uv, 128, 512, WUKV, 512, scr, r, lane); }
              if (rebal) rope_table((float2*)(ws + WS_ROPE), w0 >> 3, nw0 >> 3, tid);
              const int gt = w0 * 64 + lane, NT = nw0 * 64; v4u z = {0u, 0u, 0u, 0u};
              for (int i = gt; i < (N0 - N0_REAL) * DM / 8; i += NT) *((v4u*)(WIN0 + (size_t)N0_REAL * DM) + i) = z;
          } }
        }
    }
    SEAM(0);
    if (IN(1)) { KP_LOAD();
        if (rebal) { LAS float* scr = (LAS float*)(lds + wave * 16384);
            for (int it = gw; it < 16 * (N0_REAL / 32); it += NGW) transpose_item(kp->even_w_in, DM, N0_REAL, WIN0, 0, scr, it, lane); }
        adaln_rows(kp->x, kp->norm_w, MOD, H, gw, NGW, lane); }
    SEAM(1);
    if (IN(2)) { KP_LOAD();
        if (rebal) {
            pg8::Gemm g{H, WIN0, TOK, 2048, DM, DM}; pg8::StaticOrder S; S.init(TOK, 2048, G, bx);
            pg8::EpiStore E{P, N0, 0, 1.f};
            pg8::gemm_phase<pg8::EpiStore, pg8::StaticOrder, PG8_ALIGN, PG8_SP2>(lds, g, S, E);
        } else {
        pg8::Gemm g{H, WIN0, TOK, N0, DM, DM}; pg8::StaticOrder S; S.init(TOK, N0, G, bx);
        pg8::EpiStore E{P, N0, 0, 1.f};
        pg8::gemm_phase<pg8::EpiStore, pg8::StaticOrder, PG8_ALIGN, PG8_SP2>(lds, g, S, E);
        { constexpr int NU = (TOK / 256) * (N0 / 256); const int rem = NU % G; const bool idle = rem == 0 || bx >= rem; const int widx = rem == 0 ? bx : bx - rem, NW = rem == 0 ? G : G - rem;
          if (idle) { LAS float* scr = (LAS float*)(lds + wave * 16384);
              constexpr int I1 = 16 * 32, I2 = 16 * (N1 / 32), I4 = 4 * 24, I5 = 2 * 16, I6 = 2 * 16;
              for (int it = widx * 8 + wave; it < I1 + I2 + I4 + I5 + I6; it += NW * 8) { int r = it;
                  if (r < I4) { transpose_item(kp->b_w_uq, 256, 768, WUQ, 0, scr, r, lane); continue; } r -= I4;
                  if (r < I5) { transpose_item(kp->b_w_uk, 128, 512, WUKV, 0, scr, r, lane); continue; } r -= I5;
                  if (r < I6) { transpose_item(kp->b_w_uv, 128, 512, WUKV, 512, scr, r, lane); continue; } r -= I6;
                  if (r < I1) { transpose_item(kp->even_w_out, DM, DM, WOUT0, 0, scr, r, lane); continue; } r -= I1;
                  transpose_item(kp->odd_w_in, DM, N1, WIN1, 0, scr, r, lane); }
              rope_table((float2*)(ws + WS_ROPE), widx, NW, tid); } }
        }
    }
    SEAM(2);
    if (IN(3)) { KP_LOAD(); post_rows(kp->a_q_norm, kp->a_k_norm, kp->b_q_lora_norm, kp->b_kv_lora_norm, P, CQN, CKVN, ROPE, gw, NGW, lane); }
    SEAM(3);
    if (IN(4)) { KP_LOAD();
        if (rebal) {
            if (bx < 192) {
                { int kk = 256; asm volatile("" : "+s"(kk)); pg8::Gemm g{CQN, WUQ, TOK, 768, kk, kk}; pg8::StaticOrder S; S.init(TOK, 768, 192, bx);
                  pg8::EpiStore E{QB, 768, 768, C2B};
                  pg8::gemm_phase<pg8::EpiStore, pg8::StaticOrder, PG8_ALIGN, PG8_SP2>(lds, g, S, E); }
                { int kk = 128; asm volatile("" : "+s"(kk)); pg8::Gemm g{CKVN, WUKV, TOK, 1024, kk, kk}; pg8::StaticOrder S; S.init(TOK, 1024, 192, bx);
                  pg8::EpiStore E{KVB, 1024, 0, 1.f};
                  pg8::gemm_phase<pg8::EpiStore, pg8::StaticOrder, PG8_ALIGN, PG8_SP2>(lds, g, S, E); }
            } else {
                pg8::Gemm g{H, WIN0 + (size_t)2048 * DM, TOK, 256, DM, DM}; pg8::StaticOrder S; S.init(TOK, 256, 64, bx - 192);
                pg8::EpiStore E{P + 2048, N0, 0, 1.f};
                pg8::gemm_phase<pg8::EpiStore, pg8::StaticOrder, PG8_ALIGN, PG8_SP2>(lds, g, S, E);
            }
            { LAS float* scr = (LAS float*)(lds + wave * 16384); constexpr int I1 = 16 * 32, I2 = 16 * (N1 / 32);
              for (int it = gw; it < I1 + I2; it += NGW) { if (it < I1) transpose_item(kp->even_w_out, DM, DM, WOUT0, 0, scr, it, lane); else transpose_item(kp->odd_w_in, DM, N1, WIN1, 0, scr, it - I1, lane); } }
        } else {
        { int kk = 256; asm volatile("" : "+s"(kk)); pg8::Gemm g{CQN, WUQ, TOK, 768, kk, kk}; pg8::StaticOrder S; S.init(TOK, 768, G, bx);
          pg8::EpiStore E{QB, 768, 768, C2B};
          pg8::gemm_phase<pg8::EpiStore, pg8::StaticOrder, PG8_ALIGN, PG8_SP2>(lds, g, S, E); }
        { int kk = 128; asm volatile("" : "+s"(kk)); pg8::Gemm g{CKVN, WUKV, TOK, 1024, kk, kk}; pg8::StaticOrder S; S.init(TOK, 1024, G, bx);
          pg8::EpiStore E{KVB, 1024, 0, 1.f};
          pg8::gemm_phase<pg8::EpiStore, pg8::StaticOrder, PG8_ALIGN, PG8_SP2>(lds, g, S, E); }
        }
    }
    SEAM(4);
    if (IN(5)) { KP_LOAD();
        for (int L0 = vcu; L0 < 512; L0 += G) {
            const int L = (G == 256 && (vcu & 1)) ? (L0 ^ 256) : L0;
            if (L < 256) {
                const int bh = L >> 3, b = bh >> 3, h = bh & 7, qb = L & 7; const size_t r0 = (size_t)b * SEQ;
                att2::attn_unit<96, 0>(lds, QB + r0 * 768 + h * 96, KVB + r0 * 1024 + h * 64, P + r0 * N0 + C_KR, KVB + r0 * 1024 + 512 + h * 64, P + r0 * N0 + C_GB + h * 64, MIX + r0 * DM + 512 + h * 64,
                                       768, 1024, N0, 1024, N0, DM, qb * 512, 0, SEQ / 64, 0.f, 0.f, ROPE);
            } else {
                const int Lr = L - 256, grp = Lr >> 5, b = grp >> 1, kvh = grp & 1, h = kvh * 4 + ((Lr & 31) >> 3), qb = Lr & 7; const size_t r0 = (size_t)b * SEQ;
                const bf16* Pb = P + r0 * N0;
                att2::attn_unit<64, 0>(lds, Pb + C_QA + h * 64, Pb + C_KA + kvh * 64, Pb + C_KA + kvh * 64, Pb + C_VA + kvh * 64, Pb + C_GA + h * 64, MIX + r0 * DM + h * 64,
                                       N0, N0, N0, N0, N0, DM, qb * 512, 0, SEQ / 64, 0.f, 0.f, ROPE, kp->a_q_norm);
            }
        }
    }
    SEAM(5);
    if (IN(6)) { KP_LOAD();
        pg8::Gemm g{MIX, WOUT0, TOK, DM, DM, DM}; pg8::StaticOrder S; S.init(TOK, DM, G, bx);
        if (fuse_norm) {
            pg8::PanelRms st{(float*)(ws + WS_XB6), (unsigned*)(ws + WS_CNT6), EPS};
            pg8::EpiResNorm<false> E{kp->x, kp->out, MOD + 2048, DM, st, kp->norm_w + DM, MOD + 4 * 3072, H, KVB};
            pg8::gemm_phase<pg8::EpiResNorm<false>, pg8::StaticOrder, false, PG8_SP2>(lds, g, S, E);
        } else {
            pg8::EpiRes E{kp->x, kp->out, MOD + 2048, DM};
            pg8::gemm_phase<pg8::EpiRes, pg8::StaticOrder, PG8_ALIGN, PG8_SP2>(lds, g, S, E);
        }
    }
    SEAM(6);
    if (IN(7) && !fuse_norm) { KP_LOAD(); adaln_rows(kp->out, kp->norm_w + DM, MOD + 4 * 3072, H, gw, NGW, lane); }
    if (!fuse_norm) SEAM(7);
    if (IN(8)) { KP_LOAD();
        pg8::Gemm g{H, WIN1, TOK, N1, DM, DM}; pg8::StaticOrder S; S.init(TOK, N1, G, bx);
        pg8::EpiStore E{P, N1, 1024, C2A};
        pg8::gemm_phase<pg8::EpiStore, pg8::StaticOrder, PG8_ALIGN, PG8_SP2>(lds, g, S, E);
        { constexpr int NU = (TOK / 256) * (N1 / 256); const int rem = NU % G; const bool idle = rem == 0 || bx >= rem; const int widx = rem == 0 ? bx : bx - rem, NW = rem == 0 ? G : G - rem;
          if (idle) { LAS float* scr = (LAS float*)(lds + wave * 16384);
              for (int it = widx * 8 + wave; it < 16 * 32; it += NW * 8) transpose_item(kp->odd_w_out, DM, DM, WOUT1, 0, scr, it, lane); } }
    }
    SEAM(8);
    if (IN(9)) { KP_LOAD();
        for (int L = vcu; L < 512; L += G) {
            const int grp = L >> 5, b = grp >> 2, kvh = grp & 3, h = kvh * 4 + 2 * ((L & 31) >> 4), u = L & 15; const size_t r0 = (size_t)b * SEQ;
            const bf16* Pb = P + r0 * N1;
            att6::attn_unit_win(lds, Pb + C_QC + h * 64, Pb + C_KC + kvh * 64, Pb + C_VC + kvh * 64, Pb + C_GC + h * 64, MIX + r0 * DM + h * 64,
                                N1, DM, u * 256, u * 4 - 2, SEQ / 64, exp2f(-0.5f * (float)(h + 1)) * LOG2E, kp->c_sink[h] * LOG2E, exp2f(-0.5f * (float)(h + 2)) * LOG2E, kp->c_sink[h + 1] * LOG2E);
        }
    }
    SEAM(9);
    if (IN(10)) { KP_LOAD();
        pg8::Gemm g{MIX, WOUT1, TOK, DM, DM, DM}; pg8::StaticOrder S; S.init(TOK, DM, G, bx);
        if (fuse_norm) {
            pg8::PanelRms st{(float*)(ws + WS_XB10), (unsigned*)(ws + WS_CNT10), EPS};
            pg8::EpiResNorm<true> E{kp->out, kp->out, MOD + 4 * 3072 + 2048, DM, st, kp->final_norm, nullptr, nullptr, KVB};
            pg8::gemm_phase<pg8::EpiResNorm<true>, pg8::StaticOrder, false, PG8_SP2>(lds, g, S, E);
        } else {
            pg8::EpiRes E{kp->out, kp->out, MOD + 4 * 3072 + 2048, DM};
            pg8::gemm_phase<pg8::EpiRes, pg8::StaticOrder, PG8_ALIGN, PG8_SP2>(lds, g, S, E);
        }
    }
    if (!fuse_norm) SEAM(10);
    if (IN(11) && !fuse_norm) { KP_LOAD();
        float* outp = kp->out; const float* fnw = kp->final_norm; constexpr int NR = 4;
        for (int mb = gw; mb < TOK; mb += NR * NGW) {
            f32x4 v[NR][4]; float ss[NR]; int mr[NR];
#pragma unroll
            for (int r = 0; r < NR; ++r) { const int m = mb + r * NGW; mr[r] = m < TOK ? m : mb; const f32x4* xr = (const f32x4*)(outp + (size_t)mr[r] * DM) + lane;
#pragma unroll
                for (int j = 0; j < 4; ++j) v[r][j] = xr[64 * j]; }
#pragma unroll
            for (int r = 0; r < NR; ++r) { float s_ = 0.f;
#pragma unroll
                for (int j = 0; j < 4; ++j) s_ += (v[r][j].x * v[r][j].x + v[r][j].y * v[r][j].y) + (v[r][j].z * v[r][j].z + v[r][j].w * v[r][j].w);
                ss[r] = 1.f / sqrtf(wave_sum(s_) * (1.f / DM) + EPS); }
#pragma unroll
            for (int j = 0; j < 4; ++j) { const f32x4 w = *(const f32x4*)(fnw + 4 * (lane + 64 * j));
#pragma unroll
                for (int r = 0; r < NR; ++r) { if (r > 0 && mb + r * NGW >= TOK) continue; ((f32x4*)(outp + (size_t)mr[r] * DM) + lane)[64 * j] = v[r][j] * ss[r] * w; } }
        }
    }
#undef IN
#undef SEAM
#undef MOD
#undef ROPE
#undef WIN0
#undef WOUT0
#undef WIN1
#undef WOUT1
#undef WUQ
#undef WUKV
#undef H
#undef P
#undef QB
#undef KVB
#undef MIX
#undef CQN
#undef CKVN
}

#ifndef MK_MULTI
#define MK_MULTI 0
#endif
extern "C" void kernel_launch(void* const* d_in, const int* in_sizes, int n_in, void* d_out, int out_size, void* d_ws, size_t ws_size, hipStream_t stream) {
    static int grid = 0;
    if (grid == 0) {
        if (n_in != 18 || out_size != TOK * DM || ws_size < WS_END) { fprintf(stderr, "kernel_launch: unexpected problem (n_in %d out %d ws %zu)\n", n_in, out_size, ws_size); grid = -1; return; }
        int dev = 0, cus = 0, per_cu = 0;
        hipGetDevice(&dev); hipDeviceGetAttribute(&cus, hipDeviceAttributeMultiprocessorCount, dev);
        if (hipFuncSetAttribute((const void*)mega_fwd, hipFuncAttributeMaxDynamicSharedMemorySize, LDS_BYTES) != hipSuccess) { fprintf(stderr, "kernel_launch: hipFuncSetAttribute failed\n"); grid = -1; return; }
        if (hipOccupancyMaxActiveBlocksPerMultiprocessor(&per_cu, (const void*)mega_fwd, 512, LDS_BYTES) != hipSuccess || per_cu < 1) { fprintf(stderr, "kernel_launch: occupancy query says %d\n", per_cu); per_cu = 1; }
        (void)hipGetLastError();
        grid = cus * (per_cu > 1 ? 1 : per_cu);
    }
    if (grid < 0) return;
    if (hipMemsetAsync((char*)d_ws + WS_CTL, 0, WS_MOD + 2 * 4 * 3072 * sizeof(float), stream) != hipSuccess) {   fprintf(stderr, "kernel_launch: memset failed\n"); return; }
    Params p{};
    const float** pf = (const float**)&p;
    for (int i = 0; i < 18; ++i) pf[i] = (const float*)d_in[i];
    p.out = (float*)d_out; p.ws = (unsigned char*)d_ws;
#if MK_MULTI
    for (int k = 0; k < NPHASE; ++k) hipLaunchKernelGGL(mega_fwd, dim3(grid), dim3(512), LDS_BYTES, stream, p, k, k + 1);
#else
    int lo = 0, hi = NPHASE;
    void* args[] = {&p, &lo, &hi};
    hipError_t e = hipLaunchCooperativeKernel((void*)mega_fwd, dim3(grid), dim3(512), args, LDS_BYTES, stream);
    if (e != hipSuccess) fprintf(stderr, "cooperative launch failed: %s (grid %d)\n", hipGetErrorString(e), grid);
#endif
}
```

```cpp
#include <hip/hip_runtime.h>
#include <hip/hip_cooperative_groups.h>
#include <cstdio>
#include <cstdint>
#include <cmath>
namespace cg = cooperative_groups;
namespace pg8 {
#define PG8_LAS __attribute__((address_space(3)))
typedef unsigned short bf16_t;
typedef short bf16x8 __attribute__((ext_vector_type(8)));
typedef float f32x4 __attribute__((ext_vector_type(4)));
typedef unsigned u32x4 __attribute__((ext_vector_type(4)));
constexpr int BM = 256, BK = 64, HALF = 128, HTB = HALF * BK * 2  , STAGE_BYTES = 8 * HTB, NXCD = 8, WGM = 8;

__host__ __device__ __forceinline__ int lds_byte(int r, int c) { const int st = (r >> 4) * 2 + (c >> 5), rr = r & 15, cc = c & 31, ob = rr * 64 + cc * 2; return st * 1024 + (ob ^ (((ob >> 9) & 1) << 5)); }
__host__ __device__ __forceinline__ void stage_rc(int b, int& R, int& C) { const int st = b / 1024, sb = b % 1024, swz = sb ^ (((sb >> 9) & 1) << 5); R = (st >> 1) * 16 + swz / 64; C = (st & 1) * 32 + (swz % 64) / 2; }
__host__ __device__ __forceinline__ int perm32(int rho) { const int n = rho >> 4, i = rho & 15; return 8 * (i >> 2) + 4 * n + (i & 3); }

struct Unit { int pm, pn; };
struct Gemm { const bf16_t* A; const bf16_t* Bt; int M, N, K, lda; };

struct StaticOrder {
    int nM, nN, nwg, G, c;
    __host__ __device__ void init(int M, int N, int G_, int c_) { nM = M / BM; nN = N / BM; nwg = nM * nN; G = G_; c = c_; }
    __host__ __device__ bool next(int i, Unit& u) const {
        const long L = (long)i * G + c; if (L >= nwg) return false;
        int wgid = (int)L; { const int q = nwg / NXCD, r = nwg % NXCD, xcd = wgid % NXCD, off = wgid / NXCD; wgid = (xcd < r ? xcd * (q + 1) : r * (q + 1) + (xcd - r) * q) + off; }
        const int nig = WGM * nN, gid = wgid / nig, fm = gid * WGM, gsz = (nM - fm) < WGM ? (nM - fm) : WGM;
        u.pm = fm + ((wgid % nig) % gsz); u.pn = (wgid % nig) / gsz; return true;
    }
    __device__ __forceinline__ void a_ready(const Unit&) const {}
    __device__ __forceinline__ void done(const Unit&) const {}
};

__device__ __forceinline__ unsigned cvt_pk_bf16(float lo, float hi) { unsigned r; asm volatile("v_cvt_pk_bf16_f32 %0, %1, %2" : "=v"(r) : "v"(lo), "v"(hi)); return r; }
typedef float f32x2 __attribute__((ext_vector_type(2)));
template <class Epi, class Sched, bool ALIGN_EPI = false, bool SP2 = false>
__device__ __forceinline__ void gemm_phase(PG8_LAS unsigned char* lds, const Gemm g, const Sched& S, const Epi& E) {
    const int tid = threadIdx.x, wid = __builtin_amdgcn_readfirstlane(tid >> 6), lane = tid & 63, wr = wid >> 2, wc = wid & 3, fr = lane & 15, fq = lane >> 4;
    const int K = g.K, nt = K / BK;
    unsigned voffA[2], voffB[2];
#pragma unroll
    for (int i = 0; i < 2; ++i) { int R, C; stage_rc(tid * 16 + i * 8192, R, C); const int Rb = Epi::PERM ? ((R & ~31) + perm32(R & 31)) : R;
        voffA[i] = (unsigned)(R * g.lda + C) * 2u; voffB[i] = (unsigned)(Rb * K + C) * 2u; }
    const size_t kstep = (size_t)(BK * 2);
    const size_t hstepA = (size_t)HALF * g.lda * 2, hstepB = (size_t)HALF * K * 2;
    const size_t tstepA = 2 * hstepA, tstepB = 2 * hstepB;
    const unsigned ldsw = (unsigned)wid * 1024u;
    const int aoff = lds_byte(wr * 64 + fr, fq * 8), boff = lds_byte(wc * 32 + fr, fq * 8);
#define PG8_SA(b, h) (((b) * 2 + (h)) * HTB)
#define PG8_SB(b, h) ((4 + (b) * 2 + (h)) * HTB)
#define PG8_STAGE(bufoff, gbase, voff) do { _Pragma("unroll") for (int _i = 0; _i < 2; ++_i) \
        __builtin_amdgcn_global_load_lds((const unsigned*)((const char*)(gbase) + (voff)[_i]), (PG8_LAS unsigned*)(lds + (bufoff) + ldsw + _i * 8192), 16, 0, 0); } while (0)
#define PG8_LDA(dst, b, h) do { _Pragma("unroll") for (int m = 0; m < 4; ++m) _Pragma("unroll") for (int k = 0; k < 2; ++k) dst[m][k] = *(const PG8_LAS bf16x8*)(lds + PG8_SA(b, h) + aoff + m * 2048 + k * 1024); } while (0)
#define PG8_LDB(dst, b, h) do { _Pragma("unroll") for (int n = 0; n < 2; ++n) _Pragma("unroll") for (int k = 0; k < 2; ++k) dst[n][k] = *(const PG8_LAS bf16x8*)(lds + PG8_SB(b, h) + boff + n * 2048 + k * 1024); } while (0)
#define PG8_MMA(ai, bj, At, Bt) do { __builtin_amdgcn_s_setprio(1); _Pragma("unroll") for (int m = 0; m < 4; ++m) _Pragma("unroll") for (int n = 0; n < 2; ++n) _Pragma("unroll") for (int k = 0; k < 2; ++k) \
        acc[ai][bj][m][n] = __builtin_amdgcn_mfma_f32_16x16x32_bf16(Bt[n][k], At[m][k], acc[ai][bj][m][n], 0, 0, 0); __builtin_amdgcn_s_setprio(0); } while (0)
#define PG8_WAIT_V(n) asm volatile("s_waitcnt vmcnt(" #n ")" ::: "memory")
#define PG8_WAIT_L(n) asm volatile("s_waitcnt lgkmcnt(" #n ")" ::: "memory")
#define PG8_BAR __builtin_amdgcn_s_barrier()
#define PG8_SCHED __builtin_amdgcn_sched_barrier(0)
    Unit cur, nxt; int ui = 0;
    if (!S.next(0, cur)) return;
    f32x4 acc[2][2][4][2];
#pragma unroll
    for (int a = 0; a < 2; ++a)
#pragma unroll
        for (int b = 0; b < 2; ++b)
#pragma unroll
            for (int m = 0; m < 4; ++m)
#pragma unroll
                for (int n = 0; n < 2; ++n) acc[a][b][m][n] = (f32x4){0.f, 0.f, 0.f, 0.f};
    bf16x8 At[4][2], B0[2][2], B1[2][2];
    const char* cA = (const char*)g.A + (size_t)cur.pm * tstepA; const char* cB = (const char*)g.Bt + (size_t)cur.pn * tstepB;
    S.a_ready(cur);
    if constexpr (SP2) {
        PG8_STAGE(PG8_SB(0, 0), cB, voffB); PG8_STAGE(PG8_SB(0, 1), cB + hstepB, voffB); PG8_STAGE(PG8_SA(0, 0), cA, voffA); PG8_STAGE(PG8_SA(0, 1), cA + hstepA, voffA);
        if (wr == 1) PG8_BAR;
        PG8_WAIT_V(2); PG8_BAR;
        PG8_STAGE(PG8_SB(1, 0), cB + kstep, voffB); PG8_STAGE(PG8_SA(1, 0), cA + kstep, voffA); PG8_STAGE(PG8_SB(1, 1), cB + hstepB + kstep, voffB);
        PG8_WAIT_V(6); PG8_BAR;
    } else {
        PG8_STAGE(PG8_SB(0, 0), cB, voffB); PG8_STAGE(PG8_SA(0, 0), cA, voffA); PG8_STAGE(PG8_SB(0, 1), cB + hstepB, voffB); PG8_STAGE(PG8_SA(0, 1), cA + hstepA, voffA);
        if (wr == 1) PG8_BAR;
        PG8_WAIT_V(4); PG8_BAR;
        PG8_STAGE(PG8_SB(1, 0), cB + kstep, voffB); PG8_STAGE(PG8_SA(1, 0), cA + kstep, voffA); PG8_STAGE(PG8_SB(1, 1), cB + hstepB + kstep, voffB);
        PG8_WAIT_V(6); PG8_BAR;
    }
    for (;;) {
        const bool has_next = S.next(ui + 1, nxt);
        const char* nA = has_next ? (const char*)g.A + (size_t)nxt.pm * tstepA : cA; const char* nB = has_next ? (const char*)g.Bt + (size_t)nxt.pn * tstepB : cB;
        for (int t = 0; t < nt; t += 2) {
            const bool last = (t == nt - 2);
            const char* a1 = cA + (size_t)(t + 1) * kstep;
            const char* a2 = last ? nA : cA + (size_t)(t + 2) * kstep; const char* b2 = last ? nB : cB + (size_t)(t + 2) * kstep;
            const char* a3 = a2 + kstep; const char* b3 = b2 + kstep;
            if (last && has_next) S.a_ready(nxt);
            if constexpr (SP2) {
            PG8_LDB(B0, 0, 0); PG8_LDB(B1, 0, 1); PG8_SCHED; PG8_LDA(At, 0, 0); PG8_STAGE(PG8_SA(1, 1), a1 + hstepA, voffA);
            PG8_WAIT_V(8); PG8_WAIT_L(0); PG8_BAR; PG8_MMA(0, 0, At, B0); PG8_MMA(0, 1, At, B1); PG8_BAR; PG8_SCHED;
            PG8_LDA(At, 0, 1); PG8_STAGE(PG8_SB(0, 0), b2, voffB); PG8_STAGE(PG8_SB(0, 1), b2 + hstepB, voffB); PG8_STAGE(PG8_SA(0, 0), a2, voffA);
            PG8_WAIT_V(8); PG8_WAIT_L(0); PG8_BAR; PG8_MMA(1, 0, At, B0); PG8_MMA(1, 1, At, B1); PG8_BAR; PG8_SCHED;
            PG8_LDB(B0, 1, 0); PG8_LDB(B1, 1, 1); PG8_SCHED; PG8_LDA(At, 1, 0); PG8_STAGE(PG8_SA(0, 1), a2 + hstepA, voffA);
            PG8_WAIT_V(8); PG8_WAIT_L(0); PG8_BAR; PG8_MMA(0, 0, At, B0); PG8_MMA(0, 1, At, B1); PG8_BAR; PG8_SCHED;
            PG8_LDA(At, 1, 1); PG8_STAGE(PG8_SB(1, 0), b3, voffB); PG8_STAGE(PG8_SB(1, 1), b3 + hstepB, voffB); PG8_STAGE(PG8_SA(1, 0), a3, voffA);
            PG8_WAIT_V(8); PG8_WAIT_L(0); PG8_BAR; PG8_MMA(1, 0, At, B0); PG8_MMA(1, 1, At, B1); PG8_BAR; PG8_SCHED;
            } else {
            PG8_LDB(B0, 0, 0); PG8_SCHED; PG8_LDA(At, 0, 0); PG8_STAGE(PG8_SA(1, 1), a1 + hstepA, voffA);
            PG8_WAIT_L(8); PG8_BAR; PG8_WAIT_L(0); PG8_MMA(0, 0, At, B0); PG8_BAR; PG8_SCHED;
            PG8_LDB(B1, 0, 1); PG8_STAGE(PG8_SB(0, 0), b2, voffB);
            PG8_BAR; PG8_WAIT_L(0); PG8_MMA(0, 1, At, B1); PG8_BAR;
            PG8_LDA(At, 0, 1); PG8_STAGE(PG8_SA(0, 0), a2, voffA);
            PG8_BAR; PG8_WAIT_L(0); PG8_MMA(1, 0, At, B0); PG8_BAR; PG8_SCHED;
            PG8_STAGE(PG8_SB(0, 1), b2 + hstepB, voffB);
            PG8_WAIT_V(6); PG8_BAR; PG8_MMA(1, 1, At, B1); PG8_BAR;
            PG8_LDB(B0, 1, 0); PG8_SCHED; PG8_LDA(At, 1, 0); PG8_STAGE(PG8_SA(0, 1), a2 + hstepA, voffA);
            PG8_WAIT_L(8); PG8_BAR; PG8_WAIT_L(0); PG8_MMA(0, 0, At, B0); PG8_BAR; PG8_SCHED;
            PG8_LDB(B1, 1, 1); PG8_STAGE(PG8_SB(1, 0), b3, voffB);
            PG8_BAR; PG8_WAIT_L(0); PG8_MMA(0, 1, At, B1); PG8_BAR;
            PG8_LDA(At, 1, 1); PG8_STAGE(PG8_SA(1, 0), a3, voffA);
            PG8_BAR; PG8_WAIT_L(0); PG8_MMA(1, 0, At, B0); PG8_BAR; PG8_SCHED;
            PG8_STAGE(PG8_SB(1, 1), b3 + hstepB, voffB);
            PG8_WAIT_V(6); PG8_BAR; PG8_MMA(1, 1, At, B1); PG8_BAR;
            }
        }
        if constexpr (ALIGN_EPI) { if (wr == 0) PG8_BAR; }
        if constexpr (!Epi::AFTER_DRAIN) { E(acc, cur, wr, wc, fr, fq); S.done(cur); }
        if (!has_next) break;
#pragma unroll
        for (int a = 0; a < 2; ++a)
#pragma unroll
            for (int b = 0; b < 2; ++b)
#pragma unroll
                for (int m = 0; m < 4; ++m)
#pragma unroll
                    for (int n = 0; n < 2; ++n) acc[a][b][m][n] = (f32x4){0.f, 0.f, 0.f, 0.f};
        cur = nxt; cA = nA; cB = nB; ++ui;
        if constexpr (ALIGN_EPI) { if (wr == 1) PG8_BAR; }
    }
    PG8_WAIT_V(0);
    if constexpr (!ALIGN_EPI) { if (wr == 0) PG8_BAR; }
    PG8_BAR;
    if constexpr (Epi::AFTER_DRAIN) { E.fused(acc, cur, wr, wc, fr, fq, lds, wid, lane); S.done(cur); }
#undef PG8_SA
#undef PG8_SB
#undef PG8_STAGE
#undef PG8_LDA
#undef PG8_LDB
#undef PG8_MMA
#undef PG8_WAIT_V
#undef PG8_WAIT_L
#undef PG8_BAR
#undef PG8_SCHED
}
}
#define PG8_SP2 true
#define PG8_ALIGN true
namespace pg8 {
typedef unsigned u32x2 __attribute__((ext_vector_type(2)));
struct EpiStore {
    static constexpr bool PERM = true, AFTER_DRAIN = false;
    bf16_t* O; int ldc; int scale_cols; float scale0;
    __device__ __forceinline__ void operator()(const f32x4 (&acc)[2][2][4][2], const Unit& u, int wr, int wc, int fr, int fq) const {
        const int row0 = u.pm * BM + wr * 64 + fr; const int col0 = u.pn * BM + wc * 32 + 8 * fq;
        const float sc = (u.pn * BM < scale_cols) ? scale0 : 1.f;
#pragma unroll
        for (int ai = 0; ai < 2; ++ai)
#pragma unroll
            for (int m = 0; m < 4; ++m) { bf16_t* rowp = O + (size_t)(row0 + ai * HALF + m * 16) * ldc + col0;
#pragma unroll
                for (int bj = 0; bj < 2; ++bj) { f32x4 v0 = acc[ai][bj][m][0] * sc, v1 = acc[ai][bj][m][1] * sc;
                    u32x4 w; w.x = cvt_pk_bf16(v0[0], v0[1]); w.y = cvt_pk_bf16(v0[2], v0[3]); w.z = cvt_pk_bf16(v1[0], v1[1]); w.w = cvt_pk_bf16(v1[2], v1[3]);
                    *(u32x4*)(rowp + bj * HALF) = w; } }
    }
};
struct EpiQb {
    static constexpr bool PERM = false, AFTER_DRAIN = false;
    bf16_t* O; int ldc; const float2* rope; float sc;
    __device__ __forceinline__ void operator()(const f32x4 (&acc)[2][2][4][2], const Unit& u, int wr, int wc, int fr, int fq) const {
        const int row0 = u.pm * BM + wr * 64 + fr;
#pragma unroll
        for (int bj = 0; bj < 2; ++bj) { const int colg = u.pn * BM + bj * HALF + wc * 32; const bool is_rope = ((colg >> 5) % 3) == 2;
#pragma unroll
            for (int ai = 0; ai < 2; ++ai)
#pragma unroll
                for (int m = 0; m < 4; ++m) { const int row = row0 + ai * HALF + m * 16; f32x4 v0 = acc[ai][bj][m][0], v1 = acc[ai][bj][m][1];
                    if (is_rope) { const float2* rp = rope + (size_t)(row & 4095) * 16 + 4 * fq;
#pragma unroll
                        for (int e = 0; e < 4; ++e) { const float2 cs = rp[e]; const float x1 = v0[e], x2 = v1[e]; v0[e] = x1 * cs.x - x2 * cs.y; v1[e] = x1 * cs.y + x2 * cs.x; } }
                    v0 = v0 * sc; v1 = v1 * sc; bf16_t* rowp = O + (size_t)row * ldc + colg + 4 * fq;
                    u32x2 a, b; a.x = cvt_pk_bf16(v0[0], v0[1]); a.y = cvt_pk_bf16(v0[2], v0[3]); b.x = cvt_pk_bf16(v1[0], v1[1]); b.y = cvt_pk_bf16(v1[2], v1[3]);
                    *(u32x2*)rowp = a; *(u32x2*)(rowp + 16) = b; asm volatile("" ::: "memory"); } }
    }
};
struct EpiRes {
    static constexpr bool PERM = true, AFTER_DRAIN = false;
    const float* base; float* out; const float* gate; int ldc;
    __device__ __forceinline__ void operator()(const f32x4 (&acc)[2][2][4][2], const Unit& u, int wr, int wc, int fr, int fq) const {
        const int row0 = u.pm * BM + wr * 64 + fr; const int b = (u.pm * BM) >> 12; const int col0 = u.pn * BM + wc * 32 + 8 * fq;
#pragma unroll
        for (int bj = 0; bj < 2; ++bj) { const int col = col0 + bj * HALF; const f32x4 g0 = *(const f32x4*)(gate + (size_t)b * 3072 + col), g1 = *(const f32x4*)(gate + (size_t)b * 3072 + col + 4);
#pragma unroll
            for (int ai = 0; ai < 2; ++ai)
#pragma unroll
                for (int m = 0; m < 4; ++m) { const size_t off = (size_t)(row0 + ai * HALF + m * 16) * ldc + col;
                    const f32x4 b0 = *(const f32x4*)(base + off), b1 = *(const f32x4*)(base + off + 4);
                    *(f32x4*)(out + off) = b0 + g0 * acc[ai][bj][m][0]; *(f32x4*)(out + off + 4) = b1 + g1 * acc[ai][bj][m][1]; } }
    }
};
struct PanelRms {
    float* xbuf; unsigned* cnt; float eps;
    __device__ __forceinline__ void run(const f32x4 (&v)[2][2][4][2], const Unit& u, int wr, int wc, int fr, int fq, PG8_LAS unsigned char* lds, int wid, int lane) const {
        PG8_LAS float* Pp = (PG8_LAS float*)lds;
        PG8_LAS float* S = (PG8_LAS float*)(lds + 4096);
#pragma unroll
        for (int ai = 0; ai < 2; ++ai)
#pragma unroll
            for (int m = 0; m < 4; ++m) { float q = 0.f;
#pragma unroll
                for (int bj = 0; bj < 2; ++bj)
#pragma unroll
                    for (int n = 0; n < 2; ++n) { const f32x4 x = v[ai][bj][m][n]; q += (x[0] * x[0] + x[1] * x[1]) + (x[2] * x[2] + x[3] * x[3]); }
                q += __shfl_xor(q, 16); q += __shfl_xor(q, 32);
                if (fq == 0) Pp[(ai * HALF + wr * 64 + m * 16 + fr) * 4 + wc] = q; }
        asm volatile("s_waitcnt lgkmcnt(0)" ::: "memory"); __builtin_amdgcn_s_barrier(); asm volatile("" ::: "memory");
        const int row = wid * 32 + (lane & 31);
        if (lane < 32) { const f32x4 a = *(const PG8_LAS f32x4*)(Pp + row * 4);
            __hip_atomic_store(xbuf + ((size_t)(u.pm * BM + row) * 4 + u.pn), (a[0] + a[1]) + (a[2] + a[3]), __ATOMIC_RELAXED, __HIP_MEMORY_SCOPE_AGENT); }
        asm volatile("s_waitcnt vmcnt(0)" ::: "memory");
        if (lane == 0) __hip_atomic_fetch_add(cnt + 64 * u.pm, 1u, __ATOMIC_RELAXED, __HIP_MEMORY_SCOPE_AGENT);
        if (wid == 0) {
            for (unsigned sp = 0; sp < (1u << 22); ++sp) {
                if ((unsigned)__builtin_amdgcn_readfirstlane(__hip_atomic_load(cnt + 64 * u.pm, __ATOMIC_RELAXED, __HIP_MEMORY_SCOPE_AGENT)) >= 32u) break;
                __builtin_amdgcn_s_sleep(2); }
            __builtin_amdgcn_fence(__ATOMIC_ACQUIRE, "agent");
        }
        asm volatile("s_waitcnt vmcnt(0) lgkmcnt(0)" ::: "memory"); __builtin_amdgcn_s_barrier(); asm volatile("" ::: "memory");
        if (lane < 32) { const float* slot = xbuf + (size_t)(u.pm * BM + row) * 4; float q = 0.f;
#pragma unroll
            for (int t = 0; t < 4; ++t) q += __hip_atomic_load(slot + t, __ATOMIC_RELAXED, __HIP_MEMORY_SCOPE_AGENT);
            S[row] = 1.0f / sqrtf(q * (1.0f / 1024.0f) + eps); }
        asm volatile("s_waitcnt vmcnt(0) lgkmcnt(0)" ::: "memory"); __builtin_amdgcn_s_barrier(); asm volatile("" ::: "memory");
    }
};
template <bool FINAL> struct EpiResNorm {
    static constexpr bool PERM = true, AFTER_DRAIN = true;
    const float* base; float* out; const float* gate; int ldc; PanelRms st; const float* nw; const float* modn; bf16_t* Hn; bf16_t* x1b;
    __device__ __forceinline__ void operator()(const f32x4 (&)[2][2][4][2], const Unit&, int, int, int, int) const {}
    __device__ __forceinline__ void fused(f32x4 (&acc)[2][2][4][2], const Unit& u, int wr, int wc, int fr, int fq, PG8_LAS unsigned char* lds, int wid, int lane) const {
        const int row0 = u.pm * BM + wr * 64 + fr; const int b = (u.pm * BM) >> 12; const int col0 = u.pn * BM + wc * 32 + 8 * fq;
#pragma unroll
        for (int bj = 0; bj < 2; ++bj) { const int col = col0 + bj * HALF; const f32x4 g0 = *(const f32x4*)(gate + (size_t)b * 3072 + col), g1 = *(const f32x4*)(gate + (size_t)b * 3072 + col + 4);
#pragma unroll
            for (int ai = 0; ai < 2; ++ai)
#pragma unroll
                for (int m = 0; m < 4; ++m) { const size_t off = (size_t)(row0 + ai * HALF + m * 16) * ldc + col;
                    f32x4 b0, b1;
                    if (FINAL) { const u32x4 rw = *(const u32x4*)(x1b + off);
                        b0 = (f32x4){__uint_as_float(rw.x << 16), __uint_as_float(rw.x & 0xffff0000u), __uint_as_float(rw.y << 16), __uint_as_float(rw.y & 0xffff0000u)};
                        b1 = (f32x4){__uint_as_float(rw.z << 16), __uint_as_float(rw.z & 0xffff0000u), __uint_as_float(rw.w << 16), __uint_as_float(rw.w & 0xffff0000u)}; }
                    else { b0 = *(const f32x4*)(base + off); b1 = *(const f32x4*)(base + off + 4); }
                    acc[ai][bj][m][0] = b0 + g0 * acc[ai][bj][m][0]; acc[ai][bj][m][1] = b1 + g1 * acc[ai][bj][m][1];
                    asm volatile("" : "+v"(acc[ai][bj][m][0]), "+v"(acc[ai][bj][m][1]));
                    if (m == 3) asm volatile("" ::: "memory"); } }
        f32x4 ww0[2], ww1[2], hh0[2], hh1[2];
#pragma unroll
        for (int bj = 0; bj < 2; ++bj) { const int col = col0 + bj * HALF;
            ww0[bj] = *(const f32x4*)(nw + col); ww1[bj] = *(const f32x4*)(nw + col + 4); hh0[bj] = (f32x4){0.f, 0.f, 0.f, 0.f}; hh1[bj] = hh0[bj];
            if (!FINAL) { const float* mb = modn + (size_t)b * 3072; ww0[bj] = ww0[bj] * (*(const f32x4*)(mb + 1024 + col) + 1.f); ww1[bj] = ww1[bj] * (*(const f32x4*)(mb + 1024 + col + 4) + 1.f); hh0[bj] = *(const f32x4*)(mb + col); hh1[bj] = *(const f32x4*)(mb + col + 4); } }
        st.run(acc, u, wr, wc, fr, fq, lds, wid, lane);
        const PG8_LAS float* S = (const PG8_LAS float*)(lds + 4096);
#pragma unroll
        for (int bj = 0; bj < 2; ++bj) { const int col = col0 + bj * HALF;
            const f32x4 w0 = ww0[bj], w1 = ww1[bj], h0 = hh0[bj], h1 = hh1[bj];
#pragma unroll
            for (int ai = 0; ai < 2; ++ai)
#pragma unroll
                for (int m = 0; m < 4; ++m) { const int r = ai * HALF + wr * 64 + m * 16 + fr; const float rstd = S[r]; const size_t off = (size_t)(u.pm * BM + r) * ldc + col;
                    const f32x4 x0 = acc[ai][bj][m][0], x1 = acc[ai][bj][m][1];
                    if (FINAL) { *(f32x4*)(out + off) = x0 * rstd * w0; *(f32x4*)(out + off + 4) = x1 * rstd * w1; }
                    else { { u32x4 xw; xw.x = cvt_pk_bf16(x0[0], x0[1]); xw.y = cvt_pk_bf16(x0[2], x0[3]); xw.z = cvt_pk_bf16(x1[0], x1[1]); xw.w = cvt_pk_bf16(x1[2], x1[3]); *(u32x4*)(x1b + off) = xw; }
                        const f32x4 y0 = x0 * rstd * w0 + h0, y1 = x1 * rstd * w1 + h1;
                        u32x4 w; w.x = cvt_pk_bf16(y0[0], y0[1]); w.y = cvt_pk_bf16(y0[2], y0[3]); w.z = cvt_pk_bf16(y1[0], y1[1]); w.w = cvt_pk_bf16(y1[2], y1[3]);
                        *(u32x4*)(Hn + off) = w; }
                    if (m & 1) asm volatile("" ::: "memory"); } }
    }
};
}
namespace att {
#define LAS3 __attribute__((address_space(3)))
typedef unsigned short bf16_t;
typedef short bf16x8 __attribute__((ext_vector_type(8)));
typedef short s16x4 __attribute__((ext_vector_type(4)));
typedef float f32x16 __attribute__((ext_vector_type(16)));
typedef float f32x4 __attribute__((ext_vector_type(4)));
typedef unsigned u32x4 __attribute__((ext_vector_type(4)));
typedef float f32x2_t __attribute__((ext_vector_type(2)));
typedef __bf16 bf16x2_t __attribute__((ext_vector_type(2)));
constexpr int KSLOT = 14336, VSLOT = 8192;
constexpr int L_K = 0, L_V = 2 * KSLOT, L_WS = L_V + 2 * VSLOT, L_OST = L_WS + 8 * 256, L_BYTES = L_OST + 8 * 4096;
__device__ __forceinline__ int crow(int r, int hi) { return (r & 3) + 8 * (r >> 2) + 4 * hi; }
__device__ __forceinline__ unsigned cvtpk(float lo, float hi) { f32x2_t v = {lo, hi}; bf16x2_t b = __builtin_convertvector(v, bf16x2_t); return __builtin_bit_cast(unsigned, b); }
__device__ __forceinline__ float bflo(unsigned u) { return __uint_as_float(u << 16); }
__device__ __forceinline__ float bfhi(unsigned u) { return __uint_as_float(u & 0xffff0000u); }
__device__ __forceinline__ s16x4 vtr(const LAS3 char* p) { return __builtin_bit_cast(s16x4, __builtin_amdgcn_ds_read_tr16_b64_v4i16((LAS3 s16x4*)p)); }
__device__ __forceinline__ float swapmax(float m) { auto rr = __builtin_amdgcn_permlane32_swap(__float_as_uint(m), __float_as_uint(m), false, false); return fmaxf(__uint_as_float(rr[0]), __uint_as_float(rr[1])); }
__device__ __forceinline__ float swapsum(float m) { auto rr = __builtin_amdgcn_permlane32_swap(__float_as_uint(m), __float_as_uint(m), false, false); return __uint_as_float(rr[0]) + __uint_as_float(rr[1]); }
__device__ __forceinline__ float silu_f(float g) { return g * __builtin_amdgcn_rcpf(1.f + __builtin_amdgcn_exp2f(-1.4426950408889634f * g)); }

__device__ __forceinline__ void glds16s(const void* sbase, unsigned voff, unsigned lds_dst) { unsigned keep;
    asm volatile("s_mov_b32 %0, m0\n\ts_mov_b32 m0, %3\n\ts_nop 0\n\tglobal_load_lds_dwordx4 %1, %2\n\ts_mov_b32 m0, %0" : "=&s"(keep) : "v"(voff), "s"(sbase), "s"(lds_dst) : "memory"); }
}
namespace att2 {
using namespace att;
constexpr int M_K = 0, M_V = 2 * KSLOT, M_WS = M_V + 2 * VSLOT, M_OST = M_WS + 8 * 512, M_BYTES = M_OST + 8 * 8192;
__device__ __forceinline__ void softmax_half(f32x16& p0, f32x16& p1, float& m, float& l, f32x16& o0, f32x16& o1, LAS3 float* wsf, u32x4 (&pw)[4], int hi, int r32) {
    float ra = fmaxf(fmaxf(p0[0], p0[1]), p1[0]), rb = fmaxf(fmaxf(p0[2], p0[3]), p1[1]); ra = fmaxf(fmaxf(ra, p1[2]), p1[3]);
#pragma unroll
    for (int r = 4; r < 16; r += 4) { ra = fmaxf(fmaxf(ra, p0[r]), p0[r + 1]); rb = fmaxf(fmaxf(rb, p0[r + 2]), p0[r + 3]); ra = fmaxf(fmaxf(ra, p1[r]), p1[r + 1]); rb = fmaxf(fmaxf(rb, p1[r + 2]), p1[r + 3]); }
    const float rm = swapmax(fmaxf(ra, rb));
    const float mn = fmaxf(m, rm);
    if (__any(rm > m + 8.0f)) {
        const float alpha = __builtin_amdgcn_exp2f(m - mn);
        l *= alpha; m = mn;
        if (hi == 0) wsf[r32] = alpha;
        asm volatile("s_waitcnt lgkmcnt(0)" ::: "memory");
#pragma unroll
        for (int r4 = 0; r4 < 4; ++r4) { const f32x4 al = *(const LAS3 f32x4*)(wsf + 8 * r4 + 4 * hi);
#pragma unroll
            for (int e = 0; e < 4; ++e) { o0[4 * r4 + e] *= al[e]; o1[4 * r4 + e] *= al[e]; } }
        asm volatile("s_waitcnt lgkmcnt(0)" ::: "memory");
    }
    float s0 = 0.f, s1 = 0.f;
#pragma unroll
    for (int r = 0; r < 16; ++r) { p0[r] = __builtin_amdgcn_exp2f(p0[r] - m); p1[r] = __builtin_amdgcn_exp2f(p1[r] - m); s0 += p0[r]; s1 += p1[r]; }
    l += s0 + s1;
#pragma unroll
    for (int e = 0; e < 4; ++e) { pw[0][e] = cvtpk(p0[2 * e], p0[2 * e + 1]); pw[1][e] = cvtpk(p0[8 + 2 * e], p0[8 + 2 * e + 1]);
                                  pw[2][e] = cvtpk(p1[2 * e], p1[2 * e + 1]); pw[3][e] = cvtpk(p1[8 + 2 * e], p1[8 + 2 * e + 1]); }
}
__device__ __forceinline__ void rope_q(bf16x8& q1, bf16x8& q2, const float2* rp) {
    const u32x4 x1 = __builtin_bit_cast(u32x4, q1), x2 = __builtin_bit_cast(u32x4, q2); u32x4 y1, y2;
#pragma unroll
    for (int e = 0; e < 4; ++e) { const float2 c0 = rp[2 * e], c1 = rp[2 * e + 1];
        const float a0 = bflo(x1[e]), a1 = bfhi(x1[e]), b0 = bflo(x2[e]), b1 = bfhi(x2[e]);
        y1[e] = cvtpk(a0 * c0.x - b0 * c0.y, a1 * c1.x - b1 * c1.y); y2[e] = cvtpk(a0 * c0.y + b0 * c0.x, a1 * c1.y + b1 * c1.x); }
    q1 = __builtin_bit_cast(bf16x8, y1); q2 = __builtin_bit_cast(bf16x8, y2);
}
__device__ __forceinline__ void stage_half(const f32x16& o0, const f32x16& o1, float l, LAS3 float* wsf, LAS3 bf16_t* stg, int hi, int r32) {
    l = swapsum(l);
    if (hi == 0) wsf[32 + r32] = l;
    asm volatile("s_waitcnt lgkmcnt(0)" ::: "memory");
#pragma unroll
    for (int r4 = 0; r4 < 4; ++r4) { const f32x4 lv = *(const LAS3 f32x4*)(wsf + 32 + 8 * r4 + 4 * hi);
#pragma unroll
        for (int e = 0; e < 4; ++e) { const int r = 4 * r4 + e; const float rl = __builtin_amdgcn_rcpf(lv[e]); const int orow = crow(r, hi);
            stg[orow * 64 + r32] = (bf16_t)(cvtpk(o0[r] * rl, 0.f) & 0xffffu); stg[orow * 64 + 32 + r32] = (bf16_t)(cvtpk(o1[r] * rl, 0.f) & 0xffffu); } }
}
__device__ __forceinline__ void qproc_a(bf16x8 (&q)[4], const float* g, const float2* rope, int pos_seq, int hi, float osc) {
    float x[4][8]; float ss = 0.f;
#pragma unroll
    for (int d0 = 0; d0 < 4; ++d0) { const u32x4 u = __builtin_bit_cast(u32x4, q[d0]);
#pragma unroll
        for (int e = 0; e < 4; ++e) { x[d0][2 * e] = bflo(u[e]); x[d0][2 * e + 1] = bfhi(u[e]); ss += x[d0][2 * e] * x[d0][2 * e] + x[d0][2 * e + 1] * x[d0][2 * e + 1]; } }
    ss = swapsum(ss);
    const float rstd = 1.0f / sqrtf(ss * (1.0f / 64.0f) + 1e-6f);
    const float2* rr = rope + (size_t)(pos_seq >> 6) * 16 + 8 * hi; const float2* rc = rope + (size_t)(pos_seq & 63) * 16 + 8 * hi;
#pragma unroll
    for (int d0 = 0; d0 < 4; ++d0)
#pragma unroll
        for (int e = 0; e < 8; ++e) x[d0][e] *= rstd * g[16 * d0 + 8 * hi + e];
    u32x4 y[4];
#pragma unroll
    for (int e = 0; e < 4; ++e) { float a[2], b[2], c[2], d[2];
#pragma unroll
        for (int k = 0; k < 2; ++k) { const float2 cr = rr[2 * e + k], cc = rc[2 * e + k]; const float x1 = x[0][2 * e + k], x2 = x[1][2 * e + k], z1 = x[2][2 * e + k], z2 = x[3][2 * e + k];
            a[k] = (x1 * cr.x - x2 * cr.y) * osc; b[k] = (x1 * cr.y + x2 * cr.x) * osc; c[k] = (z1 * cc.x - z2 * cc.y) * osc; d[k] = (z1 * cc.y + z2 * cc.x) * osc; }
        y[0][e] = cvtpk(a[0], a[1]); y[1][e] = cvtpk(b[0], b[1]); y[2][e] = cvtpk(c[0], c[1]); y[3][e] = cvtpk(d[0], d[1]); }
#pragma unroll
    for (int d0 = 0; d0 < 4; ++d0) q[d0] = __builtin_bit_cast(bf16x8, y[d0]);
}
__device__ __forceinline__ void softmax_rel(f32x16& p0, f32x16& p1, float& m, float& l, f32x16& o0, f32x16& o1, LAS3 float* wsf, u32x4 (&pw)[4], bool first, int hi, int r32) {
    float ra = fmaxf(fmaxf(p0[0], p0[1]), p1[0]), rb = fmaxf(fmaxf(p0[2], p0[3]), p1[1]); ra = fmaxf(fmaxf(ra, p1[2]), p1[3]);
#pragma unroll
    for (int r = 4; r < 16; r += 4) { ra = fmaxf(fmaxf(ra, p0[r]), p0[r + 1]); rb = fmaxf(fmaxf(rb, p0[r + 2]), p0[r + 3]); ra = fmaxf(fmaxf(ra, p1[r]), p1[r + 1]); rb = fmaxf(fmaxf(rb, p1[r + 2]), p1[r + 3]); }
    const float rml = fmaxf(ra, rb);
    if (first || __any(rml > 8.0f)) {
        const float rm = swapmax(rml);
        const float mt = m + (first ? rm : fmaxf(rm, 0.f));
        const unsigned mb = cvtpk(mt, 0.f) & 0xffffu; const float mn = __uint_as_float(mb << 16);
        const float delta = mn - m;
#pragma unroll
        for (int r = 0; r < 16; ++r) { p0[r] -= delta; p1[r] -= delta; }
        const float alpha = first ? 1.f : __builtin_amdgcn_exp2f(-delta);
        l *= alpha; m = mn;
        if (hi == 0) wsf[r32] = alpha;
        asm volatile("s_waitcnt lgkmcnt(0)" ::: "memory");
#pragma unroll
        for (int r4 = 0; r4 < 4; ++r4) { const f32x4 al = *(const LAS3 f32x4*)(wsf + 8 * r4 + 4 * hi);
#pragma unroll
            for (int e = 0; e < 4; ++e) { o0[4 * r4 + e] *= al[e]; o1[4 * r4 + e] *= al[e]; } }
        asm volatile("s_waitcnt lgkmcnt(0)" ::: "memory");
    }
    float s0 = 0.f, s1 = 0.f;
#pragma unroll
    for (int r = 0; r < 16; ++r) { p0[r] = __builtin_amdgcn_exp2f(p0[r]); p1[r] = __builtin_amdgcn_exp2f(p1[r]); s0 += p0[r]; s1 += p1[r]; }
    l += s0 + s1;
#pragma unroll
    for (int e = 0; e < 4; ++e) { pw[0][e] = cvtpk(p0[2 * e], p0[2 * e + 1]); pw[1][e] = cvtpk(p0[8 + 2 * e], p0[8 + 2 * e + 1]);
                                  pw[2][e] = cvtpk(p1[2 * e], p1[2 * e + 1]); pw[3][e] = cvtpk(p1[8 + 2 * e], p1[8 + 2 * e + 1]); }
}
template <int DQK, int MODE>
__device__ __forceinline__ void attn_unit(LAS3 unsigned char* lds, const bf16_t* aQ, const bf16_t* aK, const bf16_t* aK2, const bf16_t* aV, const bf16_t* aG, bf16_t* aO,
                                          const int a_qp, const int a_kp, const int a_k2p, const int a_vp, const int a_gp, const int a_op, const int a_q0, const int a_t_lo, const int a_t_hi,
                                          const float a_slope2, const float a_sink2, const float2* aRope, const float* aQn = nullptr) {
    constexpr int ND = DQK / 16;
    const int tid = threadIdx.x, lane = tid & 63, r32 = lane & 31, hi = lane >> 5; const int wid = __builtin_amdgcn_readfirstlane(tid >> 6);
    const int qw = a_q0 + wid * 64;
    bf16x8 qA[ND], qB[ND];
    { const bf16_t* Qw = aQ + (size_t)(qw + r32) * a_qp + hi * 8;
#pragma unroll
      for (int d0 = 0; d0 < ND; ++d0) { qA[d0] = *(const bf16x8*)(Qw + d0 * 16); qB[d0] = *(const bf16x8*)(Qw + (size_t)32 * a_qp + d0 * 16); } }
    if (DQK == 96) { rope_q(qA[ND - 2], qA[ND - 1], aRope + (size_t)(qw + r32) * 16 + 8 * hi); rope_q(qB[ND - 2], qB[ND - 1], aRope + (size_t)(qw + 32 + r32) * 16 + 8 * hi); }
    if constexpr (DQK == 64) { if (aQn) {
        qproc_a(qA, aQn, aRope, qw + r32, hi, 0.125f * 1.4426950408889634f);
#pragma unroll
        for (int d0 = 0; d0 < 4; ++d0) asm volatile("" : "+v"(qA[d0]));
        asm volatile("" ::: "memory");
        qproc_a(qB, aQn, aRope, qw + 32 + r32, hi, 0.125f * 1.4426950408889634f);
#pragma unroll
        for (int d0 = 0; d0 < 4; ++d0) asm volatile("" : "+v"(qB[d0]));
        asm volatile("" ::: "memory"); } }
    const unsigned koffg = (unsigned)(lane * a_kp + wid * 8) * 2u, k2offg = (unsigned)(lane * a_k2p + (wid & 3) * 8) * 2u, voffg = (unsigned)((16 * (wid & 3) + (lane >> 2)) * a_vp + (wid >> 2) * 32 + (lane & 3) * 8) * 2u;
    const unsigned lds0 = (unsigned)(uintptr_t)lds;
    const unsigned kdst = (unsigned)__builtin_amdgcn_readfirstlane(lds0 + M_K + wid * 1024), vdst = (unsigned)__builtin_amdgcn_readfirstlane(lds0 + M_V + wid * 1024);
    LAS3 float* wsfA = (LAS3 float*)(lds + M_WS + wid * 512); LAS3 float* wsfB = wsfA + 64;
#define AT_DMA(t, buf) do { glds16s(aK + (size_t)(t) * 64 * a_kp, koffg, kdst + (buf) * KSLOT); \
        if (DQK == 96 && wid < 4) glds16s(aK2 + (size_t)(t) * 64 * a_k2p, k2offg, kdst + (buf) * KSLOT + 8192); \
        glds16s(aV + (size_t)(t) * 64 * a_vp, voffg, vdst + (buf) * VSLOT); } while (0)
    float mA = (MODE == 1) ? a_sink2 : 0.f, mB = mA;
    float lA = (MODE == 1 && hi == 0) ? 1.f : 0.f, lB = lA;
    f32x16 oA0, oA1, oB0, oB1;
#pragma unroll
    for (int r = 0; r < 16; ++r) { oA0[r] = 0.f; oA1[r] = 0.f; oB0[r] = 0.f; oB1[r] = 0.f; }
    if (MODE == 0) {
        if (tid < 256) { const int bufi = tid >> 7, ch = (tid >> 6) & 1, row = tid & 63; const u32x4 one = {0x00003F80u, 0u, 0u, 0u}, zero = {0u, 0u, 0u, 0u};
            *(LAS3 u32x4*)(lds + M_K + bufi * KSLOT + (2 * ND + ch) * 1024 + row * 16) = ch ? zero : one; } }
    AT_DMA(a_t_lo, 0);
#pragma unroll
    for (int d0 = 0; d0 < ND; ++d0) asm volatile("" : "+v"(qA[d0]), "+v"(qB[d0]));
    asm volatile("s_waitcnt vmcnt(0)" ::: "memory"); __syncthreads();
    const int koff = hi * 1024 + r32 * 16;
    const int voff = ((lane >> 4) & 1) * 32 + (lane & 3) * 8 + (4 * hi + ((lane & 15) >> 2)) * 64;
    for (int t = a_t_lo; t < a_t_hi; ++t) {
        const int cur = (t - a_t_lo) & 1;
        if (t + 1 < a_t_hi) AT_DMA(t + 1, cur ^ 1);
        bool active = true;
        if (MODE == 1) { const int k0 = t * 64; active = (k0 + 63 >= qw - 128) && (k0 <= qw + 63 + 128); }
        if (active) {
            f32x16 pA0, pA1, pB0, pB1;
#pragma unroll
            for (int r = 0; r < 16; ++r) { pA0[r] = 0.f; pA1[r] = 0.f; pB0[r] = 0.f; pB1[r] = 0.f; }
            const LAS3 char* kb = (const LAS3 char*)(lds + M_K + cur * KSLOT + koff);
#pragma unroll
            for (int d0 = 0; d0 < ND; ++d0) {
                const bf16x8 b0 = *(const LAS3 bf16x8*)(kb + d0 * 2048), b1 = *(const LAS3 bf16x8*)(kb + d0 * 2048 + 512);
                pA0 = __builtin_amdgcn_mfma_f32_32x32x16_bf16(b0, qA[d0], pA0, 0, 0, 0);
                pA1 = __builtin_amdgcn_mfma_f32_32x32x16_bf16(b1, qA[d0], pA1, 0, 0, 0);
                pB0 = __builtin_amdgcn_mfma_f32_32x32x16_bf16(b0, qB[d0], pB0, 0, 0, 0);
                pB1 = __builtin_amdgcn_mfma_f32_32x32x16_bf16(b1, qB[d0], pB1, 0, 0, 0);
            }
            if (MODE == 0) {
                const bf16x8 b0 = *(const LAS3 bf16x8*)(kb + ND * 2048), b1 = *(const LAS3 bf16x8*)(kb + ND * 2048 + 512);
                const u32x4 qxA = {hi == 0 ? (__float_as_uint(-mA) >> 16) : 0u, 0u, 0u, 0u}, qxB = {hi == 0 ? (__float_as_uint(-mB) >> 16) : 0u, 0u, 0u, 0u};
                const bf16x8 fa = __builtin_bit_cast(bf16x8, qxA), fb = __builtin_bit_cast(bf16x8, qxB);
                pA0 = __builtin_amdgcn_mfma_f32_32x32x16_bf16(b0, fa, pA0, 0, 0, 0); pA1 = __builtin_amdgcn_mfma_f32_32x32x16_bf16(b1, fa, pA1, 0, 0, 0);
                pB0 = __builtin_amdgcn_mfma_f32_32x32x16_bf16(b0, fb, pB0, 0, 0, 0); pB1 = __builtin_amdgcn_mfma_f32_32x32x16_bf16(b1, fb, pB1, 0, 0, 0);
            }
            if (MODE == 1) { const int rel0 = t * 64 + 4 * hi - (qw + r32);
#pragma unroll
                for (int r = 0; r < 16; ++r) { const int d = rel0 + (r & 3) + 8 * (r >> 2);
                    const int a0 = d < 0 ? -d : d, a1 = (d + 32) < 0 ? -(d + 32) : (d + 32), a2 = (d - 32) < 0 ? -(d - 32) : (d - 32);
                    pA0[r] = (a0 <= 128) ? pA0[r] - a_slope2 * (float)a0 : -INFINITY; pA1[r] = (a1 <= 128) ? pA1[r] - a_slope2 * (float)a1 : -INFINITY;
                    pB0[r] = (a2 <= 128) ? pB0[r] - a_slope2 * (float)a2 : -INFINITY; pB1[r] = (a0 <= 128) ? pB1[r] - a_slope2 * (float)a0 : -INFINITY; } }
            u32x4 pwA[4], pwB[4];
            if (MODE == 0) { softmax_rel(pA0, pA1, mA, lA, oA0, oA1, wsfA, pwA, t == a_t_lo, hi, r32); softmax_rel(pB0, pB1, mB, lB, oB0, oB1, wsfB, pwB, t == a_t_lo, hi, r32); }
            else { softmax_half(pA0, pA1, mA, lA, oA0, oA1, wsfA, pwA, hi, r32); softmax_half(pB0, pB1, mB, lB, oB0, oB1, wsfB, pwB, hi, r32); }
            const LAS3 char* vb = (const LAS3 char*)(lds + M_V + cur * VSLOT + voff);
#pragma unroll
            for (int ks = 0; ks < 4; ++ks) {
                const s16x4 a0 = vtr(vb + ks * 1024), a1 = vtr(vb + ks * 1024 + 512), c0 = vtr(vb + 4096 + ks * 1024), c1 = vtr(vb + 4096 + ks * 1024 + 512);
                const bf16x8 v0 = {a0[0], a0[1], a0[2], a0[3], a1[0], a1[1], a1[2], a1[3]}, v1 = {c0[0], c0[1], c0[2], c0[3], c1[0], c1[1], c1[2], c1[3]};
                const bf16x8 pa = __builtin_bit_cast(bf16x8, pwA[ks]), pb = __builtin_bit_cast(bf16x8, pwB[ks]);
                oA0 = __builtin_amdgcn_mfma_f32_32x32x16_bf16(pa, v0, oA0, 0, 0, 0);
                oA1 = __builtin_amdgcn_mfma_f32_32x32x16_bf16(pa, v1, oA1, 0, 0, 0);
                oB0 = __builtin_amdgcn_mfma_f32_32x32x16_bf16(pb, v0, oB0, 0, 0, 0);
                oB1 = __builtin_amdgcn_mfma_f32_32x32x16_bf16(pb, v1, oB1, 0, 0, 0);
            }
        }
        asm volatile("s_waitcnt vmcnt(0)" ::: "memory"); __syncthreads();
    }
    LAS3 bf16_t* stg = (LAS3 bf16_t*)(lds + M_OST + wid * 8192);
    stage_half(oA0, oA1, lA, wsfA, stg, hi, r32);
    stage_half(oB0, oB1, lB, wsfB, stg + 32 * 64, hi, r32);
    asm volatile("s_waitcnt lgkmcnt(0)" ::: "memory");
#pragma unroll
    for (int i = 0; i < 8; ++i) { const int row = i * 8 + (lane >> 3), ch = lane & 7;
        const u32x4 ov = *(const LAS3 u32x4*)(stg + row * 64 + ch * 8);
        const u32x4 gv = *(const u32x4*)(aG + (size_t)(qw + row) * a_gp + ch * 8);
        u32x4 w;
#pragma unroll
        for (int e = 0; e < 4; ++e) w[e] = cvtpk(bflo(ov[e]) * silu_f(bflo(gv[e])), bfhi(ov[e]) * silu_f(bfhi(gv[e])));
        *(u32x4*)(aO + (size_t)(qw + row) * a_op + ch * 8) = w; }
    asm volatile("s_waitcnt lgkmcnt(0)" ::: "memory");
#undef AT_DMA
}
}
namespace att6 {
using namespace att;
constexpr int TSLOT = 16384;
constexpr int X_R = 0, X_WS = 5 * TSLOT, X_OST = X_WS + 8 * 512, X_BYTES = X_OST + 8 * 4096;
__device__ __forceinline__ void attn_unit_win(LAS3 unsigned char* lds, const bf16_t* aQ, const bf16_t* aK, const bf16_t* aV, const bf16_t* aG, bf16_t* aO,
                                              const int pitch, const int a_op, const int a_q0, const int tile0  , const int ntiles_seq,
                                              const float slopeA, const float sinkA, const float slopeB, const float sinkB) {
    const int tid = threadIdx.x, lane = tid & 63, r32 = lane & 31, hi = lane >> 5; const int wid = __builtin_amdgcn_readfirstlane(tid >> 6);
    const int qw = a_q0 + wid * 32;
    const unsigned koffg = (unsigned)(lane * pitch + wid * 8) * 2u, voffg = (unsigned)((16 * (wid & 3) + (lane >> 2)) * pitch + (wid >> 2) * 32 + (lane & 3) * 8) * 2u;
    const unsigned lds0 = (unsigned)(uintptr_t)lds;
    const unsigned kdst = (unsigned)__builtin_amdgcn_readfirstlane(lds0 + X_R + wid * 1024), vdst = kdst + 8192u;
#define A6_DMA(j) do { int tt_ = tile0 + (j); tt_ = tt_ < 0 ? 0 : (tt_ >= ntiles_seq ? ntiles_seq - 1 : tt_); const unsigned so_ = (unsigned)(((j) % 5) * TSLOT); \
        glds16s(aK + (size_t)tt_ * 64 * pitch, koffg, kdst + so_); glds16s(aV + (size_t)tt_ * 64 * pitch, voffg, vdst + so_); } while (0)
    A6_DMA(0); A6_DMA(1); A6_DMA(2); A6_DMA(3);
    bf16x8 qA[4], qB[4];
    { const bf16_t* Qw = aQ + (size_t)(qw + r32) * pitch + hi * 8;
#pragma unroll
      for (int d0 = 0; d0 < 4; ++d0) { qA[d0] = *(const bf16x8*)(Qw + d0 * 16); qB[d0] = *(const bf16x8*)(Qw + 64 + d0 * 16); } }
#pragma unroll
    for (int d0 = 0; d0 < 4; ++d0) asm volatile("" : "+v"(qA[d0]), "+v"(qB[d0]));
    LAS3 float* wsfA = (LAS3 float*)(lds + X_WS + wid * 512); LAS3 float* wsfB = wsfA + 64;
    float mA = sinkA, mB = sinkB, lA = (hi == 0) ? 1.f : 0.f, lB = lA;
    f32x16 oA0, oA1, oB0, oB1;
#pragma unroll
    for (int r = 0; r < 16; ++r) { oA0[r] = 0.f; oA1[r] = 0.f; oB0[r] = 0.f; oB1[r] = 0.f; }
    const int koff = hi * 1024 + r32 * 16;
    const int voff = 8192 + ((lane >> 4) & 1) * 32 + (lane & 3) * 8 + (4 * hi + ((lane & 15) >> 2)) * 64;
    asm volatile("s_waitcnt vmcnt(0) lgkmcnt(0)\n\ts_barrier" ::: "memory");
#pragma unroll 1
    for (int s = 0; s < 5; ++s) {
        if (s < 4) { int tt_ = tile0 + s + 4; tt_ = tt_ < 0 ? 0 : (tt_ >= ntiles_seq ? ntiles_seq - 1 : tt_); const unsigned so_ = (unsigned)((s == 0 ? 4 : s - 1) * TSLOT);
            glds16s(aK + (size_t)tt_ * 64 * pitch, koffg, kdst + so_); glds16s(aV + (size_t)tt_ * 64 * pitch, voffg, vdst + so_); }
        const int j = (wid >> 1) + s;
        const int t = tile0 + j; const int k0 = t * 64;
        const int slot = (j >= 5 ? j - 5 : j) * TSLOT;
        if (t >= 0 && t < ntiles_seq) {
            f32x16 pA0, pA1, pB0, pB1;
#pragma unroll
            for (int r = 0; r < 16; ++r) { pA0[r] = 0.f; pA1[r] = 0.f; pB0[r] = 0.f; pB1[r] = 0.f; }
            const LAS3 char* kb = (const LAS3 char*)(lds + X_R + slot + koff);
#pragma unroll
            for (int d0 = 0; d0 < 4; ++d0) {
                const bf16x8 b0 = *(const LAS3 bf16x8*)(kb + d0 * 2048), b1 = *(const LAS3 bf16x8*)(kb + d0 * 2048 + 512);
                pA0 = __builtin_amdgcn_mfma_f32_32x32x16_bf16(b0, qA[d0], pA0, 0, 0, 0); pA1 = __builtin_amdgcn_mfma_f32_32x32x16_bf16(b1, qA[d0], pA1, 0, 0, 0);
                pB0 = __builtin_amdgcn_mfma_f32_32x32x16_bf16(b0, qB[d0], pB0, 0, 0, 0); pB1 = __builtin_amdgcn_mfma_f32_32x32x16_bf16(b1, qB[d0], pB1, 0, 0, 0);
            }
            { const float fd0 = (float)(k0 + 4 * hi - (qw + r32));
#pragma unroll
              for (int r = 0; r < 16; ++r) { const float t0 = fd0 + (float)((r & 3) + 8 * (r >> 2)), t1 = t0 + 32.f;
                  pA0[r] = __builtin_fmaf(-slopeA, __builtin_fabsf(t0), pA0[r]); pA1[r] = __builtin_fmaf(-slopeA, __builtin_fabsf(t1), pA1[r]);
                  pB0[r] = __builtin_fmaf(-slopeB, __builtin_fabsf(t0), pB0[r]); pB1[r] = __builtin_fmaf(-slopeB, __builtin_fabsf(t1), pB1[r]);
                  if (s == 0 || s == 4) { const bool in0 = __builtin_fabsf(t0) <= 128.f, in1 = __builtin_fabsf(t1) <= 128.f;
                      pA0[r] = in0 ? pA0[r] : -INFINITY; pA1[r] = in1 ? pA1[r] : -INFINITY; pB0[r] = in0 ? pB0[r] : -INFINITY; pB1[r] = in1 ? pB1[r] : -INFINITY; } } }
            u32x4 pwA[4], pwB[4];
            att2::softmax_half(pA0, pA1, mA, lA, oA0, oA1, wsfA, pwA, hi, r32);
            att2::softmax_half(pB0, pB1, mB, lB, oB0, oB1, wsfB, pwB, hi, r32);
            const LAS3 char* vb = (const LAS3 char*)(lds + X_R + slot + voff);
#pragma unroll
            for (int ks = 0; ks < 4; ++ks) {
                const s16x4 a0 = vtr(vb + ks * 1024), a1 = vtr(vb + ks * 1024 + 512), c0 = vtr(vb + 4096 + ks * 1024), c1 = vtr(vb + 4096 + ks * 1024 + 512);
                const bf16x8 v0 = {a0[0], a0[1], a0[2], a0[3], a1[0], a1[1], a1[2], a1[3]}, v1 = {c0[0], c0[1], c0[2], c0[3], c1[0], c1[1], c1[2], c1[3]};
                const bf16x8 pa = __builtin_bit_cast(bf16x8, pwA[ks]), pb = __builtin_bit_cast(bf16x8, pwB[ks]);
                oA0 = __builtin_amdgcn_mfma_f32_32x32x16_bf16(pa, v0, oA0, 0, 0, 0); oA1 = __builtin_amdgcn_mfma_f32_32x32x16_bf16(pa, v1, oA1, 0, 0, 0);
                oB0 = __builtin_amdgcn_mfma_f32_32x32x16_bf16(pb, v0, oB0, 0, 0, 0); oB1 = __builtin_amdgcn_mfma_f32_32x32x16_bf16(pb, v1, oB1, 0, 0, 0);
            }
        }
        asm volatile("s_waitcnt vmcnt(0) lgkmcnt(0)\n\ts_barrier" ::: "memory");
    }
    LAS3 bf16_t* stg = (LAS3 bf16_t*)(lds + X_OST + wid * 4096);
#pragma unroll
    for (int hd = 0; hd < 2; ++hd) {
        if (hd == 0) att2::stage_half(oA0, oA1, lA, wsfA, stg, hi, r32); else att2::stage_half(oB0, oB1, lB, wsfB, stg, hi, r32);
        asm volatile("s_waitcnt lgkmcnt(0)" ::: "memory");
#pragma unroll
        for (int i = 0; i < 4; ++i) { const int row = i * 8 + (lane >> 3), ch = lane & 7;
            const u32x4 ov = *(const LAS3 u32x4*)(stg + row * 64 + ch * 8);
            const u32x4 gv = *(const u32x4*)(aG + (size_t)(qw + row) * pitch + hd * 64 + ch * 8);
            u32x4 w;
#pragma unroll
            for (int e = 0; e < 4; ++e) w[e] = cvtpk(bflo(ov[e]) * silu_f(bflo(gv[e])), bfhi(ov[e]) * silu_f(bfhi(gv[e])));
            *(u32x4*)(aO + (size_t)(qw + row) * a_op + hd * 64 + ch * 8) = w; }
        asm volatile("s_waitcnt vmcnt(0) lgkmcnt(0)" ::: "memory");
    }
#undef A6_DMA
}
}
#define GAS __attribute__((address_space(1)))
#define LAS __attribute__((address_space(3)))
typedef unsigned short bf16;
typedef unsigned v4u __attribute__((ext_vector_type(4)));
typedef unsigned v2u __attribute__((ext_vector_type(2)));
typedef float f32x4 __attribute__((ext_vector_type(4)));
constexpr int DM = 1024, NBATCH = 4, SEQ = 4096, TOK = NBATCH * SEQ;
constexpr int N0 = 2304, N0_REAL = 2208, N1 = 2560;
constexpr int C_QA = 0, C_KA = 512, C_VA = 640, C_GA = 768, C_CQ = 1280, C_CKV = 1536, C_KR = 1664, C_GB = 1696;
constexpr int C_QC = 0, C_KC = 1024, C_VC = 1280, C_GC = 1536;
constexpr float EPS = 1e-6f, LOG2E = 1.4426950408889634f;
constexpr float C2A = 0.125f * LOG2E;
constexpr float C2B = 0.10206207261596577f * LOG2E;
constexpr size_t MiB = 1u << 20;
constexpr size_t WS_CTL = 0, CTL_ZERO_BYTES = 49152;
constexpr size_t WS_CNT6 = 16384, WS_CNT10 = 32768, WS_XB6 = 256 * 1024, WS_XB10 = 512 * 1024;
constexpr size_t WS_MOD = 64 * 1024, WS_ROPE = 1 * MiB + 256 * 1024;
constexpr size_t WS_WIN0 = 2 * MiB, WS_WOUT0 = 7 * MiB, WS_WIN1 = 9 * MiB, WS_WOUT1 = 14 * MiB, WS_WUQ = 16 * MiB, WS_WUKV = 16 * MiB + 512 * 1024;
constexpr size_t WS_H = 32 * MiB, WS_P = 64 * MiB, WS_QB = 144 * MiB, WS_KVB = 168 * MiB, WS_MIX = 200 * MiB, WS_CQN = 232 * MiB, WS_CKVN = 240 * MiB, WS_END = 244 * MiB;
constexpr int LDS_BYTES = 147456;
static_assert(att2::M_BYTES <= 131072 && att6::X_BYTES <= LDS_BYTES - 64, "attention LDS");

struct Params {
    const float *x, *c, *norm_w, *ada_w, *ada_b, *even_w_in, *a_q_norm, *a_k_norm, *b_q_lora_norm, *b_kv_lora_norm, *b_w_uq, *b_w_uk, *b_w_uv, *even_w_out, *odd_w_in, *c_sink, *odd_w_out, *final_norm;
    float* out; unsigned char* ws;
};

__device__ __forceinline__ unsigned f2bf(float f) { unsigned u = __builtin_bit_cast(unsigned, f); return (u + 0x7fffu + ((u >> 16) & 1u)) >> 16; }
__device__ __forceinline__ unsigned pk2(float lo, float hi) { return f2bf(lo) | (f2bf(hi) << 16); }
__device__ __forceinline__ float bflo(unsigned u) { return __uint_as_float(u << 16); }
__device__ __forceinline__ float bfhi(unsigned u) { return __uint_as_float(u & 0xffff0000u); }
__device__ __forceinline__ float wave_sum(float v) {
#pragma unroll
    for (int o = 1; o < 64; o <<= 1) v += __shfl_xor(v, o);
    return v;
}
#define LDS_WAIT() asm volatile("s_waitcnt lgkmcnt(0)" ::: "memory")

__device__ __forceinline__ void transpose_item(const float* W, int K, int N, bf16* WT, int row_off, LAS float* scr, int item, int lane) {
    const int nblk = N / 32, kb = item / nblk, nb = item % nblk, k0 = 64 * kb, n0 = 32 * nb;
#pragma unroll 8
    for (int i = 0; i < 32; ++i) { const int kk = 2 * i + (lane >> 5); scr[kk * 33 + (lane & 31)] = W[(size_t)(k0 + kk) * N + n0 + (lane & 31)]; }
    LDS_WAIT(); asm volatile("" ::: "memory");
    const int c = lane & 7;
#pragma unroll
    for (int j = 0; j < 4; ++j) { const int n = (lane >> 3) + 8 * j; const LAS float* s = scr + (8 * c) * 33 + n;
        v4u o; o.x = pk2(s[0 * 33], s[1 * 33]); o.y = pk2(s[2 * 33], s[3 * 33]); o.z = pk2(s[4 * 33], s[5 * 33]); o.w = pk2(s[6 * 33], s[7 * 33]);
        *(v4u*)(WT + (size_t)(row_off + n0 + n) * K + k0 + 8 * c) = o; }
    LDS_WAIT(); asm volatile("" ::: "memory");
}

__device__ __forceinline__ void adaln_rows(const float* xin, const float* nw, const float* mod  , bf16* H, int gw, int NGW, int lane) {
    constexpr int NR = 4;
    for (int mb = gw; mb < TOK; mb += NR * NGW) {
        f32x4 v[NR][4]; float ss[NR]; int mr[NR];
#pragma unroll
        for (int r = 0; r < NR; ++r) { const int m = mb + r * NGW; mr[r] = m < TOK ? m : mb; const f32x4* xr = (const f32x4*)(xin + (size_t)mr[r] * DM) + lane;
#pragma unroll
            for (int j = 0; j < 4; ++j) v[r][j] = xr[64 * j]; }
#pragma unroll
        for (int r = 0; r < NR; ++r) { float s = 0.f;
#pragma unroll
            for (int j = 0; j < 4; ++j) s += (v[r][j].x * v[r][j].x + v[r][j].y * v[r][j].y) + (v[r][j].z * v[r][j].z + v[r][j].w * v[r][j].w);
            ss[r] = 1.f / sqrtf(wave_sum(s) * (1.f / DM) + EPS); }
#pragma unroll
        for (int j = 0; j < 4; ++j) { const int cidx = 4 * (lane + 64 * j); const f32x4 w = *(const f32x4*)(nw + cidx);
#pragma unroll
            for (int r = 0; r < NR; ++r) { if (r > 0 && mb + r * NGW >= TOK) continue; const float* mbp = mod + (size_t)(mr[r] >> 12) * 3072;
                const f32x4 sh = *(const f32x4*)(mbp + cidx), sc = *(const f32x4*)(mbp + 1024 + cidx); const f32x4 h = v[r][j] * ss[r] * w * (sc + 1.f) + sh;
                v2u o; o.x = pk2(h.x, h.y); o.y = pk2(h.z, h.w); *(v2u*)(H + (size_t)mr[r] * DM + cidx) = o; } }
    }
}

struct PostRaw { v4u k; v2u cq; unsigned ckv; unsigned r1, r2; float2 cs[8]; float2 ckr; };
__device__ __forceinline__ void post_load(PostRaw& R, const bf16* pr, int m, const float2* rope, int lane) {
    R.k = *(const v4u*)(pr + C_KA + 8 * (lane & 15)); R.cq = *(const v2u*)(pr + C_CQ + 4 * lane); R.ckv = *(const unsigned*)(pr + C_CKV + 2 * lane);
    R.r1 = pr[C_KR + (lane & 15)]; R.r2 = pr[C_KR + 16 + (lane & 15)];
    const int j = lane & 7, s = m & 4095; const float2* rp = rope + (size_t)((j < 4) ? (s >> 6) : (s & 63)) * 16 + 8 * (j & 1);
#pragma unroll
    for (int e = 0; e < 8; ++e) R.cs[e] = rp[e];
    R.ckr = rope[(size_t)s * 16 + (lane & 15)];
}
__device__ __forceinline__ v4u post_head(const v4u raw, const float* g8, const float2 (&rp)[8], int j, float osc) {
    float xv[8];
#pragma unroll
    for (int e = 0; e < 4; ++e) { xv[2 * e] = bflo(raw[e]); xv[2 * e + 1] = bfhi(raw[e]); }
    float ss = 0.f;
#pragma unroll
    for (int e = 0; e < 8; ++e) ss += xv[e] * xv[e];
    ss += __shfl_xor(ss, 1); ss += __shfl_xor(ss, 2); ss += __shfl_xor(ss, 4);
    const float rstd = 1.f / sqrtf(ss * (1.f / 64.f) + EPS);
    float y[8];
#pragma unroll
    for (int e = 0; e < 8; ++e) { const float xn = xv[e] * rstd * g8[e]; const float pt = __shfl_xor(xn, 2); const float2 cs = rp[e];
        y[e] = ((j & 2) == 0 ? xn * cs.x - pt * cs.y : pt * cs.y + xn * cs.x) * osc; }
    v4u o; o.x = pk2(y[0], y[1]); o.y = pk2(y[2], y[3]); o.z = pk2(y[4], y[5]); o.w = pk2(y[6], y[7]); return o;
}
__device__ __forceinline__ void post_compute(const PostRaw& R, int m, bf16* pr, const float* a_q_norm, const float* a_k_norm, const float* b_q_lora_norm, const float* b_kv_lora_norm,
                                             bf16* CQN, bf16* CKVN, const float2* rope, int lane) {
    const int j = lane & 7;
    const v4u ok = post_head(R.k, a_k_norm + 8 * j, R.cs, j, 1.f);
    if (lane < 16) *(v4u*)(pr + C_KA + 8 * lane) = ok;
    {
        const float a0 = bflo(R.cq.x), a1 = bfhi(R.cq.x), a2 = bflo(R.cq.y), a3 = bfhi(R.cq.y);
        const float rstd = 1.f / sqrtf(wave_sum((a0 * a0 + a1 * a1) + (a2 * a2 + a3 * a3)) * (1.f / 256.f) + EPS);
        const f32x4 g = *(const f32x4*)(b_q_lora_norm + 4 * lane);
        v2u o; o.x = pk2(a0 * rstd * g.x, a1 * rstd * g.y); o.y = pk2(a2 * rstd * g.z, a3 * rstd * g.w); *(v2u*)(CQN + (size_t)m * 256 + 4 * lane) = o;
    }
    {
        const float a0 = bflo(R.ckv), a1 = bfhi(R.ckv);
        const float rstd = 1.f / sqrtf(wave_sum(a0 * a0 + a1 * a1) * (1.f / 128.f) + EPS);
        const float2 g = *(const float2*)(b_kv_lora_norm + 2 * lane);
        *(unsigned*)(CKVN + (size_t)m * 128 + 2 * lane) = pk2(a0 * rstd * g.x, a1 * rstd * g.y);
    }
    if (lane < 16) {
        const float x1 = __uint_as_float(R.r1 << 16), x2 = __uint_as_float(R.r2 << 16);
        const float2 cs = R.ckr;
        pr[C_KR + lane] = (bf16)f2bf(x1 * cs.x - x2 * cs.y); pr[C_KR + 16 + lane] = (bf16)f2bf(x1 * cs.y + x2 * cs.x);
    }
}
__device__ __forceinline__ void post_rows(const float* a_q_norm, const float* a_k_norm, const float* b_q_lora_norm, const float* b_kv_lora_norm, bf16* P, bf16* CQN, bf16* CKVN, const float2* rope, int gw, int NGW, int lane) {
    constexpr int NR = 4;
    for (int mb = gw; mb < TOK; mb += NR * NGW) {
        PostRaw R[NR];
#pragma unroll
        for (int r = 0; r < NR; ++r) { const int m = mb + r * NGW; post_load(R[r], P + (size_t)(m < TOK ? m : mb) * N0, m < TOK ? m : mb, rope, lane); }
#pragma unroll
        for (int r = 0; r < NR; ++r) { const int m = mb + r * NGW; if (m < TOK) post_compute(R[r], m, P + (size_t)m * N0, a_q_norm, a_k_norm, b_q_lora_norm, b_kv_lora_norm, CQN, CKVN, rope, lane); }
    }
}
typedef unsigned v4u_xb;
#define RLX_AGENT __ATOMIC_RELAXED, __HIP_MEMORY_SCOPE_AGENT
#define XB_TMO      128
#define XB_XCNT(j)  (256  + 64 * (j))
#define XB_XSUB(j)  (1280 + 64 * (j))
#define XB_XGEN(j)  (2304 + 64 * (j))
#define XB_TOP      3328
#define XB_TOPGEN   3392
#define XCD_BAR_WORDS 3456
#define XB_SPIN_CAP (1u << 18)

__device__ __forceinline__ unsigned xb_ld(unsigned* p)              { return __hip_atomic_load(p, __ATOMIC_RELAXED, __HIP_MEMORY_SCOPE_AGENT); }
__device__ __forceinline__ unsigned xb_add(unsigned* p, unsigned v) { return __hip_atomic_fetch_add(p, v, __ATOMIC_RELAXED, __HIP_MEMORY_SCOPE_AGENT); }
__device__ __forceinline__ unsigned xb_xcc_id() { return (unsigned)__builtin_amdgcn_s_getreg((3 << 11) | 20) & 0xFu; }
#define XB_SPIN(cond, bar) do { unsigned _sp = 0; while (cond) { __builtin_amdgcn_s_sleep(1); \
    if ((++_sp & 255u) == 0u) { if (xb_ld(&(bar)[XB_TMO])) break; if (_sp > XB_SPIN_CAP) { atomicAdd(&(bar)[XB_TMO], 1u); break; } } } } while (0)

struct XcdBarrier {
    unsigned* bar; unsigned x;
    volatile LAS unsigned* st;
};
__device__ __forceinline__ XcdBarrier xcd_barrier_post(unsigned* bar, volatile LAS unsigned* st) {
    XcdBarrier b; b.bar = bar; b.x = xb_xcc_id(); b.st = st;
    if (threadIdx.x == 0) (void)xb_add(&bar[XB_XCNT(b.x)], 1u);
    return b;
}
__device__ __forceinline__ void xcd_barrier_complete(unsigned* bar, unsigned x, unsigned& nloc, unsigned& nx) {
    const unsigned G = gridDim.x * gridDim.y * gridDim.z;
    unsigned sum, cnt, mine, sp = 0u;
    for (;;) {
        sum = 0u; cnt = 0u; mine = 0u;
#pragma unroll
        for (unsigned j = 0; j < 16; ++j) { const unsigned c = xb_ld(&bar[XB_XCNT(j)]); sum += c; cnt += (c > 0u) ? 1u : 0u; mine = (j == x) ? c : mine; }
        if (sum == G) break;
        __builtin_amdgcn_s_sleep(1);
        if ((++sp & 255u) == 0u) { if (xb_ld(&bar[XB_TMO])) break; if (sp > XB_SPIN_CAP) { atomicAdd(&bar[XB_TMO], 1u); break; } }
    }
    nloc = mine > 0u ? mine : 1u; nx = cnt > 0u ? cnt : 1u;
}

__device__ __forceinline__ void xcd_barrier(const XcdBarrier& b) {
    asm volatile("s_waitcnt vmcnt(0)" ::: "memory");
    __syncthreads();
    if (threadIdx.x == 0) {
        unsigned* bar = b.bar;
        __builtin_amdgcn_s_waitcnt(0);
        unsigned nloc = b.st[0], nx = b.st[1];
        if (nloc == 0u) { xcd_barrier_complete(bar, b.x, nloc, nx); b.st[0] = nloc; b.st[1] = nx; }
        const unsigned old = xb_add(&bar[XB_XSUB(b.x)], 1u);
        const unsigned gen = old / nloc;
        if (old + 1u == (gen + 1u) * nloc) {
            __builtin_amdgcn_fence(__ATOMIC_RELEASE, "agent");
            asm volatile("s_waitcnt vmcnt(0)" ::: "memory");
            const unsigned og = xb_add(&bar[XB_TOP], 1u);
            const unsigned tg = og / nx;
            if (og + 1u == (tg + 1u) * nx) xb_add(&bar[XB_TOPGEN], 1u);
            else XB_SPIN(xb_ld(&bar[XB_TOPGEN]) == tg, bar);
            __builtin_amdgcn_fence(__ATOMIC_ACQUIRE, "agent");
            xb_add(&bar[XB_XGEN(b.x)], 1u);
            asm volatile("s_waitcnt vmcnt(0)" ::: "memory");
        } else {
            XB_SPIN(xb_ld(&bar[XB_XGEN(b.x)]) == gen, bar);
            __builtin_amdgcn_fence(__ATOMIC_ACQUIRE, "agent");
            asm volatile("s_waitcnt vmcnt(0)" ::: "memory");
        }
    }
    __syncthreads();
}

__device__ __forceinline__ void rope_table(float2* R, int widx, int NW, int tid) {
    for (int i = widx * 512 + tid; i < 4096 * 16; i += NW * 512) { const int pos = i >> 4, fi = i & 15; const float inv = powf(10000.0f, -(float)fi * (1.0f / 16.0f)); const float ang = (float)pos * inv;
        R[i] = make_float2((float)cos((double)ang), (float)sin((double)ang)); }
}
constexpr int NPHASE = 12;
__global__ void __launch_bounds__(512, 2) mega_fwd(Params p, int ph_lo, int ph_hi) {
    extern __shared__ __attribute__((aligned(16))) unsigned char lds_raw[];
    LAS unsigned char* lds = (LAS unsigned char*)lds_raw;
    cg::grid_group grid = cg::this_grid();
    const int tid = threadIdx.x, lane = tid & 63, wave = __builtin_amdgcn_readfirstlane(tid >> 6);
    const int G = gridDim.x, bx = blockIdx.x;
    const int vcu = (G % 8 == 0) ? (bx % 8) * (G / 8) + bx / 8 : bx;
    const int gw = vcu * 8 + wave, NGW = G * 8;
    const bool rebal = (G == 256);
    const bool fuse_norm = (G == 256) && (ph_hi - ph_lo == NPHASE);
    typedef const __attribute__((address_space(4))) Params* KPtr;
#define KP_LOAD() KPtr kp = (KPtr)__builtin_amdgcn_kernarg_segment_ptr(); asm volatile("" : "+s"(kp)); unsigned char* ws = kp->ws; (void)ws
#define MOD ((float*)(ws + WS_MOD))
#define ROPE ((const float2*)(ws + WS_ROPE))
#define WIN0 ((bf16*)(ws + WS_WIN0))
#define WOUT0 ((bf16*)(ws + WS_WOUT0))
#define WIN1 ((bf16*)(ws + WS_WIN1))
#define WOUT1 ((bf16*)(ws + WS_WOUT1))
#define WUQ ((bf16*)(ws + WS_WUQ))
#define WUKV ((bf16*)(ws + WS_WUKV))
#define H ((bf16*)(ws + WS_H))
#define P ((bf16*)(ws + WS_P))
#define QB ((bf16*)(ws + WS_QB))
#define KVB ((bf16*)(ws + WS_KVB))
#define MIX ((bf16*)(ws + WS_MIX))
#define CQN ((bf16*)(ws + WS_CQN))
#define CKVN ((bf16*)(ws + WS_CKVN))
#ifndef PH_MASK
#define PH_MASK 0xfff
#endif
#define IN(k) (((PH_MASK >> (k)) & 1) && ph_lo <= (k) && (k) < ph_hi)
    volatile LAS unsigned* xb_st = (volatile LAS unsigned*)(lds + LDS_BYTES - 64);
    if (tid < 16) xb_st[tid] = 0u;
    __syncthreads();
    XcdBarrier xbar = xcd_barrier_post((unsigned*)(p.ws + WS_CTL), xb_st);
    if (ph_hi - ph_lo > 1) grid.sync();
#define SEAM(k) do { if (IN(k) && IN((k) + 1)) xcd_barrier(xbar); } while (0)

    if (IN(0)) { KP_LOAD();
        LAS float* scr = (LAS float*)(lds + wave * 16384);
        if (rebal) {
            if (vcu < 192) {
                LAS float* red = (LAS float*)(lds + 131072);
                const int l = vcu / 96, rem = vcu % 96, kh = rem & 1, kb = kh * 512 + wave * 64, jc = (rem >> 1) * 64 + lane;
                for (int i = lane; i < 256; i += 64) { const float cv = kp->c[(i >> 6) * DM + kb + (i & 63)]; scr[i] = cv / (1.f + __expf(-cv)); }
                LDS_WAIT(); asm volatile("" ::: "memory");
                const float* w = kp->ada_w + (size_t)l * DM * 3072 + (size_t)kb * 3072 + jc;
                float a0 = 0.f, a1 = 0.f, a2 = 0.f, a3 = 0.f;
#pragma unroll 16
                for (int i = 0; i < 64; ++i) { const float wv = w[(size_t)i * 3072]; a0 += scr[i] * wv; a1 += scr[64 + i] * wv; a2 += scr[128 + i] * wv; a3 += scr[192 + i] * wv; }
                red[(wave * 4 + 0) * 64 + lane] = a0; red[(wave * 4 + 1) * 64 + lane] = a1; red[(wave * 4 + 2) * 64 + lane] = a2; red[(wave * 4 + 3) * 64 + lane] = a3;
                __syncthreads();
                if (wave < 4) { float sum = kh == 0 ? kp->ada_b[l * 3072 + jc] : 0.f;
#pragma unroll
                    for (int w8 = 0; w8 < 8; ++w8) sum += red[(w8 * 4 + wave) * 64 + lane];
                    __hip_atomic_fetch_add((float*)(ws + WS_MOD) + (size_t)l * 4 * 3072 + (size_t)wave * 3072 + jc, sum, __ATOMIC_RELAXED, __HIP_MEMORY_SCOPE_AGENT); }
            } else {
                const int w0 = (vcu - 192) * 8 + wave, nw0 = (G - 192) * 8; constexpr int I4 = 4 * 24, I5 = 2 * 16, I6 = 2 * 16;
                for (int it = w0; it < I4 + I5 + I6; it += nw0) { int r = it;
                    if (r < I4) { transpose_item(kp->b_w_uq, 256, 768, WUQ, 0, scr, r, lane); continue; } r -= I4;
                    if (r < I5) { transpose_item(kp->b_w_uk, 128, 512, WUKV, 0, scr, r, lane); continue; } r -= I5;
                    transpose_item(kp->b_w_uv, 128, 512, WUKV, 512, scr, r, lane); }
                rope_table((float2*)(ws + WS_ROPE), w0 >> 3, nw0 >> 3, tid);
                const int gt = w0 * 64 + lane, NT = nw0 * 64; v4u z = {0u, 0u, 0u, 0u};
                for (int i = gt; i < (N0 - N0_REAL) * DM / 8; i += NT) *((v4u*)(WIN0 + (size_t)N0_REAL * DM) + i) = z;
            }
        } else {
        for (int it = vcu; it < 96; it += G) {
            LAS float* red = (LAS float*)(lds + 131072);
            const int kb = wave * 128;
            for (int i = lane; i < 512; i += 64) { const float cv = kp->c[(i >> 7) * DM + kb + (i & 127)]; scr[i] = cv / (1.f + __expf(-cv)); }
            LDS_WAIT(); asm volatile("" ::: "memory");
            const int l = it / 48, jc = (it % 48) * 64 + lane; const float* w = kp->ada_w + (size_t)l * DM * 3072 + (size_t)kb * 3072 + jc;
            float a0 = 0.f, a1 = 0.f, a2 = 0.f, a3 = 0.f;
#pragma unroll 16
            for (int i = 0; i < 128; ++i) { const float wv = w[(size_t)i * 3072]; a0 += scr[i] * wv; a1 += scr[128 + i] * wv; a2 += scr[256 + i] * wv; a3 += scr[384 + i] * wv; }
            red[(wave * 4 + 0) * 64 + lane] = a0; red[(wave * 4 + 1) * 64 + lane] = a1; red[(wave * 4 + 2) * 64 + lane] = a2; red[(wave * 4 + 3) * 64 + lane] = a3;
            __syncthreads();
            if (wave < 4) { float sum = kp->ada_b[l * 3072 + jc];
#pragma unroll
                for (int w8 = 0; w8 < 8; ++w8) sum += red[(w8 * 4 + wave) * 64 + lane];
                ((float*)(ws + WS_MOD))[(size_t)l * 4 * 3072 + (size_t)wave * 3072 + jc] = sum; }
            __syncthreads();
        }
        { const bool split = G > 96; const int w0 = split ? (vcu - 96) * 8 + wave : gw, nw0 = split ? (G - 96) * 8 : NGW;
          if (!split || vcu >= 96) {
              constexpr int I0 = 16 * (N0_REAL / 32), I4 = 4 * 24, I5 = 2 * 16, I6 = 2 * 16;
              for (int it = w0; it < I0 + (rebal ? I4 + I5 + I6 : 0); it += nw0) { int r = it;
                  if (r < I0) { transpose_item(kp->even_w_in, DM, N0_REAL, WIN0, 0, scr, r, lane); continue; } r -= I0;
                  if (r < I4) { transpose_item(kp->b_w_uq, 256, 768, WUQ, 0, scr, r, lane); continue; } r -= I4;
                  if (r < I5) { transpose_item(kp->b_w_uk, 128, 512, WUKV, 0, scr, r, lane); continue; } r -= I5;
                  transpose_item(kp->b_w_uv, 128, 512, WUKV, 512, scr, r, lane); }
              if (rebal) rope_table((float2*)(ws + WS_ROPE), w0 >> 3, nw0 >> 3, tid);
              const int gt = w0 * 64 + lane, NT = nw0 * 64; v4u z = {0u, 0u, 0u, 0u};
              for (int i = gt; i < (N0 - N0_REAL) * DM / 8; i += NT) *((v4u*)(WIN0 + (size_t)N0_REAL * DM) + i) = z;
          } }
        }
    }
    SEAM(0);
    if (IN(1)) { KP_LOAD();
        if (rebal) { LAS float* scr = (LAS float*)(lds + wave * 16384);
            for (int it = gw; it < 16 * (N0_REAL / 32); it += NGW) transpose_item(kp->even_w_in, DM, N0_REAL, WIN0, 0, scr, it, lane); }
        adaln_rows(kp->x, kp->norm_w, MOD, H, gw, NGW, lane); }
    SEAM(1);
    if (IN(2)) { KP_LOAD();
        if (rebal) {
            pg8::Gemm g{H, WIN0, TOK, 2048, DM, DM}; pg8::StaticOrder S; S.init(TOK, 2048, G, bx);
            pg8::EpiStore E{P, N0, 0, 1.f};
            pg8::gemm_phase<pg8::EpiStore, pg8::StaticOrder, PG8_ALIGN, PG8_SP2>(lds, g, S, E);
        } else {
        pg8::Gemm g{H, WIN0, TOK, N0, DM, DM}; pg8::StaticOrder S; S.init(TOK, N0, G, bx);
        pg8::EpiStore E{P, N0, 0, 1.f};
        pg8::gemm_phase<pg8::EpiStore, pg8::StaticOrder, PG8_ALIGN, PG8_SP2>(lds, g, S, E);
        { constexpr int NU = (TOK / 256) * (N0 / 256); const int rem = NU % G; const bool idle = rem == 0 || bx >= rem; const int widx = rem == 0 ? bx : bx - rem, NW = rem == 0 ? G : G - rem;
          if (idle) { LAS float* scr = (LAS float*)(lds + wave * 16384);
              constexpr int I1 = 16 * 32, I2 = 16 * (N1 / 32), I4 = 4 * 24, I5 = 2 * 16, I6 = 2 * 16;
              for (int it = widx * 8 + wave; it < I1 + I2 + I4 + I5 + I6; it += NW * 8) { int r = it;
                  if (r < I4) { transpose_item(kp->b_w_uq, 256, 768, WUQ, 0, scr, r, lane); continue; } r -= I4;
                  if (r < I5) { transpose_item(kp->b_w_uk, 128, 512, WUKV, 0, scr, r, lane); continue; } r -= I5;
                  if (r < I6) { transpose_item(kp->b_w_uv, 128, 512, WUKV, 512, scr, r, lane); continue; } r -= I6;
                  if (r < I1) { transpose_item(kp->even_w_out, DM, DM, WOUT0, 0, scr, r, lane); continue; } r -= I1;
                  transpose_item(kp->odd_w_in, DM, N1, WIN1, 0, scr, r, lane); }
              rope_table((float2*)(ws + WS_ROPE), widx, NW, tid); } }
        }
    }
    SEAM(2);
    if (IN(3)) { KP_LOAD(); post_rows(kp->a_q_norm, kp->a_k_norm, kp->b_q_lora_norm, kp->b_kv_lora_norm, P, CQN, CKVN, ROPE, gw, NGW, lane); }
    SEAM(3);
    if (IN(4)) { KP_LOAD();
        if (rebal) {
            if (bx < 192) {
                { int kk = 256; asm volatile("" : "+s"(kk)); pg8::Gemm g{CQN, WUQ, TOK, 768, kk, kk}; pg8::StaticOrder S; S.init(TOK, 768, 192, bx);
                  pg8::EpiStore E{QB, 768, 768, C2B};
                  pg8::gemm_phase<pg8::EpiStore, pg8::StaticOrder, PG8_ALIGN, PG8_SP2>(lds, g, S, E); }
                { int kk = 128; asm volatile("" : "+s"(kk)); pg8::Gemm g{CKVN, WUKV, TOK, 1024, kk, kk}; pg8::StaticOrder S; S.init(TOK, 1024, 192, bx);
                  pg8::EpiStore E{KVB, 1024, 0, 1.f};
                  pg8::gemm_phase<pg8::EpiStore, pg8::StaticOrder, PG8_ALIGN, PG8_SP2>(lds, g, S, E); }
            } else {
                pg8::Gemm g{H, WIN0 + (size_t)2048 * DM, TOK, 256, DM, DM}; pg8::StaticOrder S; S.init(TOK, 256, 64, bx - 192);
                pg8::EpiStore E{P + 2048, N0, 0, 1.f};
                pg8::gemm_phase<pg8::EpiStore, pg8::StaticOrder, PG8_ALIGN, PG8_SP2>(lds, g, S, E);
            }
            { LAS float* scr = (LAS float*)(lds + wave * 16384); constexpr int I1 = 16 * 32, I2 = 16 * (N1 / 32);
              for (int it = gw; it < I1 + I2; it += NGW) { if (it < I1) transpose_item(kp->even_w_out, DM, DM, WOUT0, 0, scr, it, lane); else transpose_item(kp->odd_w_in, DM, N1, WIN1, 0, scr, it - I1, lane); } }
        } else {
        { int kk = 256; asm volatile("" : "+s"(kk)); pg8::Gemm g{CQN, WUQ, TOK, 768, kk, kk}; pg8::StaticOrder S; S.init(TOK, 768, G, bx);
          pg8::EpiStore E{QB, 768, 768, C2B};
          pg8::gemm_phase<pg8::EpiStore, pg8::StaticOrder, PG8_ALIGN, PG8_SP2>(lds, g, S, E); }
        { int kk = 128; asm volatile("" : "+s"(kk)); pg8::Gemm g{CKVN, WUKV, TOK, 1024, kk, kk}; pg8::StaticOrder S; S.init(TOK, 1024, G, bx);
          pg8::EpiStore E{KVB, 1024, 0, 1.f};
          pg8::gemm_phase<pg8::EpiStore, pg8::StaticOrder, PG8_ALIGN, PG8_SP2>(lds, g, S, E); }
        }
    }
    SEAM(4);
    if (IN(5)) { KP_LOAD();
        for (int L0 = vcu; L0 < 512; L0 += G) {
            const int L = (G == 256 && (vcu & 1)) ? (L0 ^ 256) : L0;
            if (L < 256) {
                const int bh = L >> 3, b = bh >> 3, h = bh & 7, qb = L & 7; const size_t r0 = (size_t)b * SEQ;
                att2::attn_unit<96, 0>(lds, QB + r0 * 768 + h * 96, KVB + r0 * 1024 + h * 64, P + r0 * N0 + C_KR, KVB + r0 * 1024 + 512 + h * 64, P + r0 * N0 + C_GB + h * 64, MIX + r0 * DM + 512 + h * 64,
                                       768, 1024, N0, 1024, N0, DM, qb * 512, 0, SEQ / 64, 0.f, 0.f, ROPE);
            } else {
                const int Lr = L - 256, grp = Lr >> 5, b = grp >> 1, kvh = grp & 1, h = kvh * 4 + ((Lr & 31) >> 3), qb = Lr & 7; const size_t r0 = (size_t)b * SEQ;
                const bf16* Pb = P + r0 * N0;
                att2::attn_unit<64, 0>(lds, Pb + C_QA + h * 64, Pb + C_KA + kvh * 64, Pb + C_KA + kvh * 64, Pb + C_VA + kvh * 64, Pb + C_GA + h * 64, MIX + r0 * DM + h * 64,
                                       N0, N0, N0, N0, N0, DM, qb * 512, 0, SEQ / 64, 0.f, 0.f, ROPE, kp->a_q_norm);
            }
        }
    }
    SEAM(5);
    if (IN(6)) { KP_LOAD();
        pg8::Gemm g{MIX, WOUT0, TOK, DM, DM, DM}; pg8::StaticOrder S; S.init(TOK, DM, G, bx);
        if (fuse_norm) {
            pg8::PanelRms st{(float*)(ws + WS_XB6), (unsigned*)(ws + WS_CNT6), EPS};
            pg8::EpiResNorm<false> E{kp->x, kp->out, MOD + 2048, DM, st, kp->norm_w + DM, MOD + 4 * 3072, H, KVB};
            pg8::gemm_phase<pg8::EpiResNorm<false>, pg8::StaticOrder, false, PG8_SP2>(lds, g, S, E);
        } else {
            pg8::EpiRes E{kp->x, kp->out, MOD + 2048, DM};
            pg8::gemm_phase<pg8::EpiRes, pg8::StaticOrder, PG8_ALIGN, PG8_SP2>(lds, g, S, E);
        }
    }
    SEAM(6);
    if (IN(7) && !fuse_norm) { KP_LOAD(); adaln_rows(kp->out, kp->norm_w + DM, MOD + 4 * 3072, H, gw, NGW, lane); }
    if (!fuse_norm) SEAM(7);
    if (IN(8)) { KP_LOAD();
        pg8::Gemm g{H, WIN1, TOK, N1, DM, DM}; pg8::StaticOrder S; S.init(TOK, N1, G, bx);
        pg8::EpiStore E{P, N1, 1024, C2A};
        pg8::gemm_phase<pg8::EpiStore, pg8::StaticOrder, PG8_ALIGN, PG8_SP2>(lds, g, S, E);
        { constexpr int NU = (TOK / 256) * (N1 / 256); const int rem = NU % G; const bool idle = rem == 0 || bx >= rem; const int widx = rem == 0 ? bx : bx - rem, NW = rem == 0 ? G : G - rem;
          if (idle) { LAS float* scr = (LAS float*)(lds + wave * 16384);
              for (int it = widx * 8 + wave; it < 16 * 32; it += NW * 8) transpose_item(kp->odd_w_out, DM, DM, WOUT1, 0, scr, it, lane); } }
    }
    SEAM(8);
    if (IN(9)) { KP_LOAD();
        for (int L = vcu; L < 512; L += G) {
            const int grp = L >> 5, b = grp >> 2, kvh = grp & 3, h = kvh * 4 + 2 * ((L & 31) >> 4), u = L & 15; const size_t r0 = (size_t)b * SEQ;
            const bf16* Pb = P + r0 * N1;
            att6::attn_unit_win(lds, Pb + C_QC + h * 64, Pb + C_KC + kvh * 64, Pb + C_VC + kvh * 64, Pb + C_GC + h * 64, MIX + r0 * DM + h * 64,
                                N1, DM, u * 256, u * 4 - 2, SEQ / 64, exp2f(-0.5f * (float)(h + 1)) * LOG2E, kp->c_sink[h] * LOG2E, exp2f(-0.5f * (float)(h + 2)) * LOG2E, kp->c_sink[h + 1] * LOG2E);
        }
    }
    SEAM(9);
    if (IN(10)) { KP_LOAD();
        pg8::Gemm g{MIX, WOUT1, TOK, DM, DM, DM}; pg8::StaticOrder S; S.init(TOK, DM, G, bx);
        if (fuse_norm) {
            pg8::PanelRms st{(float*)(ws + WS_XB10), (unsigned*)(ws + WS_CNT10), EPS};
            pg8::EpiResNorm<true> E{kp->out, kp->out, MOD + 4 * 3072 + 2048, DM, st, kp->final_norm, nullptr, nullptr, KVB};
            pg8::gemm_phase<pg8::EpiResNorm<true>, pg8::StaticOrder, false, PG8_SP2>(lds, g, S, E);
        } else {
            pg8::EpiRes E{kp->out, kp->out, MOD + 4 * 3072 + 2048, DM};
            pg8::gemm_phase<pg8::EpiRes, pg8::StaticOrder, PG8_ALIGN, PG8_SP2>(lds, g, S, E);
        }
    }
    if (!fuse_norm) SEAM(10);
    if (IN(11) && !fuse_norm) { KP_LOAD();
        float* outp = kp->out; const float* fnw = kp->final_norm; constexpr int NR = 4;
        for (int mb = gw; mb < TOK; mb += NR * NGW) {
            f32x4 v[NR][4]; float ss[NR]; int mr[NR];
#pragma unroll
            for (int r = 0; r < NR; ++r) { const int m = mb + r * NGW; mr[r] = m < TOK ? m : mb; const f32x4* xr = (const f32x4*)(outp + (size_t)mr[r] * DM) + lane;
#pragma unroll
                for (int j = 0; j < 4; ++j) v[r][j] = xr[64 * j]; }
#pragma unroll
            for (int r = 0; r < NR; ++r) { float s_ = 0.f;
#pragma unroll
                for (int j = 0; j < 4; ++j) s_ += (v[r][j].x * v[r][j].x + v[r][j].y * v[r][j].y) + (v[r][j].z * v[r][j].z + v[r][j].w * v[r][j].w);
                ss[r] = 1.f / sqrtf(wave_sum(s_) * (1.f / DM) + EPS); }
#pragma unroll
            for (int j = 0; j < 4; ++j) { const f32x4 w = *(const f32x4*)(fnw + 4 * (lane + 64 * j));
#pragma unroll
                for (int r = 0; r < NR; ++r) { if (r > 0 && mb + r * NGW >= TOK) continue; ((f32x4*)(outp + (size_t)mr[r] * DM) + lane)[64 * j] = v[r][j] * ss[r] * w; } }
        }
    }
#undef IN
#undef SEAM
#undef MOD
#undef ROPE
#undef WIN0
#undef WOUT0
#undef WIN1
#undef WOUT1
#undef WUQ
#undef WUKV
#undef H
#undef P
#undef QB
#undef KVB
#undef MIX
#undef CQN
#undef CKVN
}

#ifndef MK_MULTI
#define MK_MULTI 0
#endif
extern "C" void kernel_launch(void* const* d_in, const int* in_sizes, int n_in, void* d_out, int out_size, void* d_ws, size_t ws_size, hipStream_t stream) {
    static int grid = 0;
    if (grid == 0) {
        if (n_in != 18 || out_size != TOK * DM || ws_size < WS_END) { fprintf(stderr, "kernel_launch: unexpected problem (n_in %d out %d ws %zu)\n", n_in, out_size, ws_size); grid = -1; return; }
        int dev = 0, cus = 0, per_cu = 0;
        hipGetDevice(&dev); hipDeviceGetAttribute(&cus, hipDeviceAttributeMultiprocessorCount, dev);
        if (hipFuncSetAttribute((const void*)mega_fwd, hipFuncAttributeMaxDynamicSharedMemorySize, LDS_BYTES) != hipSuccess) { fprintf(stderr, "kernel_launch: hipFuncSetAttribute failed\n"); grid = -1; return; }
        if (hipOccupancyMaxActiveBlocksPerMultiprocessor(&per_cu, (const void*)mega_fwd, 512, LDS_BYTES) != hipSuccess || per_cu < 1) { fprintf(stderr, "kernel_launch: occupancy query says %d\n", per_cu); per_cu = 1; }
        (void)hipGetLastError();
        grid = cus * (per_cu > 1 ? 1 : per_cu);
    }
    if (grid < 0) return;
    if (hipMemsetAsync((char*)d_ws + WS_CTL, 0, WS_MOD + 2 * 4 * 3072 * sizeof(float), stream) != hipSuccess) {   fprintf(stderr, "kernel_launch: memset failed\n"); return; }
    Params p{};
    const float** pf = (const float**)&p;
    for (int i = 0; i < 18; ++i) pf[i] = (const float*)d_in[i];
    p.out = (float*)d_out; p.ws = (unsigned char*)d_ws;
#if MK_MULTI
    for (int k = 0; k < NPHASE; ++k) hipLaunchKernelGGL(mega_fwd, dim3(grid), dim3(512), LDS_BYTES, stream, p, k, k + 1);
#else
    int lo = 0, hi = NPHASE;
    void* args[] = {&p, &lo, &hi};
    hipError_t e = hipLaunchCooperativeKernel((void*)mega_fwd, dim3(grid), dim3(512), args, LDS_BYTES, stream);
    if (e != hipSuccess) fprintf(stderr, "cooperative launch failed: %s (grid %d)\n", hipGetErrorString(e), grid);
#endif
}
```
